# Optimizing an MI355X kernel written in HIP

```python
import jax, jax.numpy as jnp
from jax import lax
import numpy as np

D_MODEL = 1024
BATCH = 8
SEQ = 4096
DEPTH = 2

HEAD_DIM = 64
N_HEADS_TOTAL = D_MODEL // HEAD_DIM
N_Q_HEADS = N_HEADS_TOTAL // 2
N_KV_HEADS = max(1, N_Q_HEADS // 4)
Q_PER_KV = N_Q_HEADS // N_KV_HEADS
ATTN_WIDTH = N_Q_HEADS * HEAD_DIM
KV_WIDTH = N_KV_HEADS * HEAD_DIM
N_SGU_GROUPS = N_HEADS_TOTAL - N_Q_HEADS
SGU_GROUP_DIM = HEAD_DIM
SGU_WIDTH = N_SGU_GROUPS * SGU_GROUP_DIM
MIX_WIDTH = ATTN_WIDTH + SGU_WIDTH
IN_WIDTH = ATTN_WIDTH + 2 * KV_WIDTH + 2 * SGU_WIDTH
WINDOW = 128
BLOCK = 128
SGU_CHUNK = 128
ROPE_THETA = 500000.0
ROPE_DIM = HEAD_DIM // 4
D_FF_DENSE = ((8 * D_MODEL // 3 + 255) // 256) * 256
N_EXPERTS = 8
TOP_K = 2
D_FF_EXPERT = 7 * D_MODEL // 2
EPS = 1e-6
N_DENSE = (DEPTH + 1) // 2
N_MOE = DEPTH // 2

kernel_name = "hybrid_swa_sink_sgu_moe_block"


def rmsnorm(x, g):
    xf = x.astype(jnp.float32)
    y = xf * lax.rsqrt(jnp.mean(xf * xf, axis=-1, keepdims=True) + EPS)
    return (y * g.astype(jnp.float32)).astype(x.dtype)


def partial_rope(t, positions):
    half = ROPE_DIM // 2
    inv_freq = jnp.power(jnp.float32(ROPE_THETA), -jnp.arange(0, ROPE_DIM, 2, dtype=jnp.float32) / ROPE_DIM)
    ang = positions.astype(jnp.float32)[..., None] * inv_freq
    cos = jnp.cos(ang)[:, :, None, :]
    sin = jnp.sin(ang)[:, :, None, :]
    tr = t[..., :ROPE_DIM].astype(jnp.float32)
    t1, t2 = tr[..., :half], tr[..., half:]
    rot = jnp.concatenate([t1 * cos - t2 * sin, t2 * cos + t1 * sin], axis=-1)
    return jnp.concatenate([rot.astype(t.dtype), t[..., ROPE_DIM:]], axis=-1)


def sliding_window_attention(q, k, v, sinks):
    B, S = q.shape[0], q.shape[1]
    nb = S // BLOCK
    qb = q.reshape(B, nb, BLOCK, N_KV_HEADS, Q_PER_KV, HEAD_DIM)

    def band(t):
        tb = t.reshape(B, nb, BLOCK, N_KV_HEADS, HEAD_DIM)
        prev = jnp.pad(tb, ((0, 0), (1, 0), (0, 0), (0, 0), (0, 0)))[:, :-1]
        return jnp.concatenate([prev, tb], axis=2)

    kb, vb = band(k), band(v)
    scores = jnp.einsum('bnqhgd,bnkhd->bnhgqk', qb, kb).astype(jnp.float32) * (HEAD_DIM ** -0.5)
    qi = jnp.arange(BLOCK)[:, None]
    kj = jnp.arange(2 * BLOCK)[None, :]
    dist = qi + BLOCK - kj
    in_window = (dist >= 0) & (dist < WINDOW)
    exists = (jnp.arange(nb)[:, None, None] > 0) | (kj >= BLOCK)[None]
    mask = in_window[None] & exists
    scores = jnp.where(mask[None, :, None, None], scores, -1e30)
    sink = sinks.astype(jnp.float32).reshape(N_KV_HEADS, Q_PER_KV)[None, None, :, :, None, None]
    sink = jnp.broadcast_to(sink, scores.shape[:-1] + (1,))
    probs = jax.nn.softmax(jnp.concatenate([scores, sink], axis=-1), axis=-1)[..., :-1]
    out = jnp.einsum('bnhgqk,bnkhd->bnqhgd', probs.astype(v.dtype), vb)
    return out.reshape(B, S, N_Q_HEADS * HEAD_DIM)


def spatial_gating(u, v, ln_g, ln_b, w_s, b_s):
    B, S = v.shape[0], v.shape[1]
    nc = S // SGU_CHUNK
    vg = v.reshape(B, S, N_SGU_GROUPS, SGU_GROUP_DIM).astype(jnp.float32)
    mu = jnp.mean(vg, axis=-1, keepdims=True)
    var = jnp.mean(jnp.square(vg - mu), axis=-1, keepdims=True)
    vn = (vg - mu) * lax.rsqrt(var + EPS)
    vn = vn * ln_g.astype(jnp.float32).reshape(N_SGU_GROUPS, SGU_GROUP_DIM) + ln_b.astype(jnp.float32).reshape(N_SGU_GROUPS, SGU_GROUP_DIM)
    vn = vn.astype(v.dtype).reshape(B, nc, SGU_CHUNK, N_SGU_GROUPS, SGU_GROUP_DIM)
    causal = jnp.tril(jnp.ones((SGU_CHUNK, SGU_CHUNK), dtype=bool))
    w = jnp.where(causal[None], w_s, jnp.zeros_like(w_s))
    mixed = jnp.einsum('gts,bcsgd->bctgd', w, vn) + b_s.T[None, None, :, :, None]
    ug = u.reshape(B, nc, SGU_CHUNK, N_SGU_GROUPS, SGU_GROUP_DIM)
    return (ug * mixed).reshape(B, S, SGU_WIDTH)


def swiglu(x, w_gate, w_up, w_down):
    return (jax.nn.silu(x @ w_gate) * (x @ w_up)) @ w_down


def moe_swiglu(x, w_router, e_gate, e_up, e_down):
    B, S, D = x.shape
    xt = x.reshape(B * S, D)
    logits = (xt @ w_router).astype(jnp.float32)
    top_vals, top_idx = lax.top_k(logits, TOP_K)
    top_w = jax.nn.softmax(top_vals, axis=-1)
    gates = jnp.sum(jax.nn.one_hot(top_idx, N_EXPERTS, dtype=jnp.float32) * top_w[..., None], axis=1)
    out = jnp.zeros((B * S, D), dtype=jnp.float32)
    for e in range(N_EXPERTS):
        h = jax.nn.silu(xt @ e_gate[e]) * (xt @ e_up[e])
        out = out + gates[:, e:e + 1] * (h @ e_down[e]).astype(jnp.float32)
    return out.astype(x.dtype).reshape(B, S, D)


def setup_inputs(seed: int = 0) -> dict:
    key = jax.random.key(seed)
    ks = jax.random.split(key, 24)
    f32 = jnp.float32

    def w(k, shape, fan_in):
        return jax.random.normal(k, shape, f32) * (fan_in ** -0.5)

    def gain(k, shape):
        return 1.0 + 0.1 * jax.random.normal(k, shape, f32)

    x = jax.random.normal(ks[0], (BATCH, SEQ, D_MODEL), f32)
    offset = jax.random.randint(ks[1], (BATCH, 1), 0, 1024, dtype=jnp.int32)
    positions = offset + jnp.arange(SEQ, dtype=jnp.int32)[None, :]
    return {
        "x": x,
        "positions": positions,
        "pre_mix_norm": gain(ks[2], (DEPTH, D_MODEL)),
        "w_in": w(ks[3], (DEPTH, D_MODEL, IN_WIDTH), D_MODEL),
        "attn_sinks": jax.random.normal(ks[4], (DEPTH, N_Q_HEADS), f32),
        "sgu_ln_g": gain(ks[5], (DEPTH, SGU_WIDTH)),
        "sgu_ln_b": 0.1 * jax.random.normal(ks[6], (DEPTH, SGU_WIDTH), f32),
        "sgu_w": w(ks[7], (DEPTH, N_SGU_GROUPS, SGU_CHUNK, SGU_CHUNK), SGU_CHUNK),
        "sgu_b": gain(ks[8], (DEPTH, N_SGU_GROUPS, SGU_CHUNK)),
        "attn_out_norm": gain(ks[9], (DEPTH, ATTN_WIDTH)),
        "sgu_out_norm": gain(ks[10], (DEPTH, SGU_WIDTH)),
        "w_out": w(ks[11], (DEPTH, MIX_WIDTH, D_MODEL), MIX_WIDTH),
        "post_mix_norm": gain(ks[12], (DEPTH, D_MODEL)),
        "pre_ffn_norm": gain(ks[13], (DEPTH, D_MODEL)),
        "post_ffn_norm": gain(ks[14], (DEPTH, D_MODEL)),
        "ffn_w_gate": w(ks[15], (N_DENSE, D_MODEL, D_FF_DENSE), D_MODEL),
        "ffn_w_up": w(ks[16], (N_DENSE, D_MODEL, D_FF_DENSE), D_MODEL),
        "ffn_w_down": w(ks[17], (N_DENSE, D_FF_DENSE, D_MODEL), D_FF_DENSE),
        "moe_router": w(ks[18], (N_MOE, D_MODEL, N_EXPERTS), D_MODEL),
        "moe_w_gate": w(ks[19], (N_MOE, N_EXPERTS, D_MODEL, D_FF_EXPERT), D_MODEL),
        "moe_w_up": w(ks[20], (N_MOE, N_EXPERTS, D_MODEL, D_FF_EXPERT), D_MODEL),
        "moe_w_down": w(ks[21], (N_MOE, N_EXPERTS, D_FF_EXPERT, D_MODEL), D_FF_EXPERT),
    }


def reference(x, positions, pre_mix_norm, w_in, attn_sinks, sgu_ln_g, sgu_ln_b, sgu_w, sgu_b,
              attn_out_norm, sgu_out_norm, w_out, post_mix_norm, pre_ffn_norm, post_ffn_norm,
              ffn_w_gate, ffn_w_up, ffn_w_down, moe_router, moe_w_gate, moe_w_up, moe_w_down):
    B, S, _ = x.shape
    cuts = [ATTN_WIDTH, ATTN_WIDTH + KV_WIDTH, ATTN_WIDTH + 2 * KV_WIDTH, ATTN_WIDTH + 2 * KV_WIDTH + SGU_WIDTH]
    h = x
    for layer in range(DEPTH):
        hn = rmsnorm(h, pre_mix_norm[layer])
        z = hn @ w_in[layer]
        q, k, v, zu, zv = jnp.split(z, cuts, axis=-1)
        q = partial_rope(q.reshape(B, S, N_Q_HEADS, HEAD_DIM), positions)
        k = partial_rope(k.reshape(B, S, N_KV_HEADS, HEAD_DIM), positions)
        v = v.reshape(B, S, N_KV_HEADS, HEAD_DIM)
        attn = sliding_window_attention(q, k, v, attn_sinks[layer])
        sgu = spatial_gating(jax.nn.gelu(zu), jax.nn.gelu(zv), sgu_ln_g[layer], sgu_ln_b[layer],
                             sgu_w[layer], sgu_b[layer])
        merged = jnp.concatenate([rmsnorm(attn, attn_out_norm[layer]),
                                  rmsnorm(sgu, sgu_out_norm[layer])], axis=-1)
        h = h + rmsnorm(merged @ w_out[layer], post_mix_norm[layer])
        y = rmsnorm(h, pre_ffn_norm[layer])
        if layer % 2 == 0:
            i = layer // 2
            f = swiglu(y, ffn_w_gate[i], ffn_w_up[i], ffn_w_down[i])
        else:
            i = layer // 2
            f = moe_swiglu(y, moe_router[i], moe_w_gate[i], moe_w_up[i], moe_w_down[i])
        h = h + rmsnorm(f, post_ffn_norm[layer])
    return h
```

```cpp
#include <hip/hip_runtime.h>
#include <cstdio>
#include <cstdint>

#ifndef MK_PER_PHASE_LAUNCH
#define MK_PER_PHASE_LAUNCH 0
#endif

#define GAS __attribute__((address_space(1)))
#define LAS __attribute__((address_space(3)))

constexpr int BATCH = 8, SEQ = 4096, D = 1024, DEPTH = 2;
constexpr int T = BATCH * SEQ;
constexpr int HD = 64, NQH = 8, NKVH = 2;
constexpr int ATTW = 512, KVW = 128, SGUW = 512, INW = 1792;
constexpr int BLK = 128;
constexpr int FFD = 2816, FFE = 3584, NEXP = 8;
constexpr float EPS = 1e-6f;
constexpr int ZQ = 0, ZK = 512, ZV = 640, ZU = 768, ZVV = 1280;
constexpr int MOE_CHUNK = 128;
constexpr int MOE_MAXT = 264;
constexpr int MOE_NCHUNK = 2;
constexpr int MOE_SPLITK = 7, MOE_TAIL_TILES = 8;
constexpr float MOE_XN_SCALE = 2.f;
constexpr float MOE_WG_SCALE = -32.f * 1.4426950408889634f, MOE_WU_SCALE = -16.f * 0.6931471805599453f * 4.f  ;
constexpr float MOE_FS_SCALE = 16.f;
constexpr float MOE_WGU_SCALE = 64.f, MOE_WD_SCALE = 128.f, MOE_HID_SCALE = 4.f;
constexpr float WOUT_SCALE = 64.f, WD_SCALE = 128.f, MERGED_SCALE = 4.f, HID_SCALE = 4.f;
constexpr unsigned E8M0_ONE = 0x7f7f7f7fu, E8M0_WGU = 0x79797979u  , E8M0_WD = 0x78787878u  , E8M0_HID = 0x7d7d7d7du  ;

namespace pg8 {
typedef unsigned short bf16_t;
typedef short bf16x8 __attribute__((ext_vector_type(8)));
typedef float f32x4 __attribute__((ext_vector_type(4)));
typedef unsigned u32x4 __attribute__((ext_vector_type(4)));
typedef int i32x4v __attribute__((ext_vector_type(4)));
constexpr int BM = 256, BK = 64, HALF = 128, HTB = HALF * BK * 2, STAGE_BYTES = 8 * HTB, NXCD = 8, WGM = 8;

__host__ __device__ __forceinline__ int lds_byte(int r, int c) { const int st = (r >> 4) * 2 + (c >> 5), rr = r & 15, cc = c & 31, ob = rr * 64 + cc * 2; return st * 1024 + (ob ^ (((ob >> 9) & 1) << 5)); }
__host__ __device__ __forceinline__ void stage_rc(int b, int& R, int& C) { const int st = b / 1024, sb = b % 1024, swz = sb ^ (((sb >> 9) & 1) << 5); R = (st >> 1) * 16 + swz / 64; C = (st & 1) * 32 + (swz % 64) / 2; }
__host__ __device__ __forceinline__ int perm32(int rho) { const int n = rho >> 4, i = rho & 15; return 8 * (i >> 2) + 4 * n + (i & 3); }

struct Unit { int pm, pn, aux; };
typedef GAS bf16_t gbf; typedef const GAS char* gcp;
struct Gemm { const gbf* A; const gbf* Bt; int K; unsigned sa, sb; int nt; unsigned sb1 = 0u; };

struct TileOrder {
    int nM, nN, nwg, G, c;
    __device__ __forceinline__ void init(int nM_, int nN_, int G_, int c_) { nM = nM_; nN = nN_; nwg = nM_ * nN_; G = G_; c = c_; }
    __device__ __forceinline__ bool next(int i, Unit& u) const {
        const long L = (long)i * G + c; if (L >= nwg) return false;
        int wgid = (int)L; { const int q = nwg / NXCD, r = nwg % NXCD, xcd = wgid % NXCD, off = wgid / NXCD; wgid = (xcd < r ? xcd * (q + 1) : r * (q + 1) + (xcd - r) * q) + off; }
        const int nig = WGM * nN, gid = wgid / nig, fm = gid * WGM, gsz = (nM - fm) < WGM ? (nM - fm) : WGM;
        u.pm = fm + ((wgid % nig) % gsz); u.pn = (wgid % nig) / gsz; u.aux = 0; return true;
    }
};
struct DenseSched : TileOrder {
    __device__ __forceinline__ gcp a_base(const Gemm& g, const Unit& u) const { return (gcp)g.A + (size_t)u.pm * ((size_t)BM * g.K * 2); }
    __device__ __forceinline__ gcp b_base(const Gemm& g, const Unit& u) const { return (gcp)g.Bt + (size_t)u.pn * ((size_t)BM * g.K * 2); }
    __device__ __forceinline__ int row(int, int) const { return 0; }
};
struct MoeSched : TileOrder {
    int pm0; const LAS int* tbl; const GAS int* inv; size_t estride;
    const LAS unsigned short* rowtab;
    gcp a1; int split;
    __device__ __forceinline__ bool next(int i, Unit& u) const { if (!TileOrder::next(i, u)) return false; u.pm += pm0; return true; }
    __device__ __forceinline__ int expert(int pm) const { int e = 0;
#pragma unroll
        for (int k = 1; k < 8; ++k) e += (pm >= tbl[k]) ? 1 : 0; return e; }
    __device__ __forceinline__ gcp a_base(const Gemm& g, const Unit& u) const { const size_t ts = (size_t)BM * g.K * 2; return u.pm < split ? (gcp)g.A + (size_t)u.pm * ts : a1 + (size_t)(u.pm - split) * ts; }
    __device__ __forceinline__ gcp b_base(const Gemm& g, const Unit& u) const { return (gcp)g.Bt + (size_t)expert(u.pm) * estride + (size_t)u.pn * ((size_t)BM * g.K * 2); }
    __device__ __forceinline__ int lookup(const Unit& u, int r) const {
        const int e = expert(u.pm), local = (u.pm - tbl[e]) * BM + r;
        return local < tbl[16 + e] ? inv[e * T + local] : 0; }
    __device__ __forceinline__ int row(int i, int r) const { return (int)rowtab[i * 256 + r]; }
};
struct MoeTailSched {
    int nunits, G, c, pm0a; const LAS int* tbl; size_t estride; int nks;
    __device__ __forceinline__ bool next(int i, Unit& u) const { const int L = i * G + c; if (L >= nunits) return false; u.aux = L % nks; const int q = L / nks; u.pn = q & 3; u.pm = 256 + (q >> 2); return true; }
    __device__ __forceinline__ int expert(int pm) const { int e = 0;
#pragma unroll
        for (int k = 1; k < 8; ++k) e += (pm >= tbl[k]) ? 1 : 0; return e; }
    __device__ __forceinline__ gcp a_base(const Gemm& g, const Unit& u) const { return (gcp)g.A + (size_t)(u.pm - pm0a) * ((size_t)BM * g.K * 2) + (size_t)u.aux * 512; }
    __device__ __forceinline__ gcp b_base(const Gemm& g, const Unit& u) const { return (gcp)g.Bt + (size_t)expert(u.pm) * estride + (size_t)u.pn * ((size_t)BM * g.K * 2) + (size_t)u.aux * 512; }
    __device__ __forceinline__ int row(int, int) const { return 0; }
};

__device__ __forceinline__ unsigned cvt_pk_bf16(float lo, float hi) { unsigned r; asm volatile("v_cvt_pk_bf16_f32 %0, %1, %2" : "=v"(r) : "v"(lo), "v"(hi)); return r; }

struct EpiStore {
    static constexpr bool PERM = true;
    gbf* O; int ldc; int pm_off; size_t aux_stride;
    __device__ __forceinline__ void operator()(const f32x4 (&acc)[2][2][4][2], const Unit& u, int wr, int wc, int fr, int fq) const {
        const int row0 = (u.pm - pm_off) * BM + wr * 64 + fr, col0 = u.pn * BM + wc * 32 + 8 * fq;
#pragma unroll
        for (int ai = 0; ai < 2; ++ai)
#pragma unroll
            for (int m = 0; m < 4; ++m) { gbf* rowp = O + (size_t)u.aux * aux_stride + (size_t)(row0 + ai * HALF + m * 16) * ldc + col0;
#pragma unroll
                for (int bj = 0; bj < 2; ++bj) { const f32x4 v0 = acc[ai][bj][m][0], v1 = acc[ai][bj][m][1];
                    u32x4 w; w.x = cvt_pk_bf16(v0[0], v0[1]); w.y = cvt_pk_bf16(v0[2], v0[3]); w.z = cvt_pk_bf16(v1[0], v1[1]); w.w = cvt_pk_bf16(v1[2], v1[3]);
                    *(GAS u32x4*)(rowp + bj * HALF) = w; } }
    }
};
__device__ __forceinline__ float silu_f(float x) { return x * __builtin_amdgcn_rcpf(1.0f + __builtin_amdgcn_exp2f(-1.4426950408889634f * x)); }
struct EpiStore8 {
    static constexpr bool PERM = true;
    GAS unsigned char* O; int ldc; int pm_off; float oscale;
    __device__ __forceinline__ unsigned pk4(f32x4 v) const {
        const float a = __builtin_amdgcn_fmed3f(v[0] * oscale, -448.f, 448.f), b = __builtin_amdgcn_fmed3f(v[1] * oscale, -448.f, 448.f), c = __builtin_amdgcn_fmed3f(v[2] * oscale, -448.f, 448.f), d = __builtin_amdgcn_fmed3f(v[3] * oscale, -448.f, 448.f);
        int w = __builtin_amdgcn_cvt_pk_fp8_f32(a, b, 0, false); w = __builtin_amdgcn_cvt_pk_fp8_f32(c, d, w, true); return (unsigned)w; }
    __device__ __forceinline__ void operator()(const f32x4 (&acc)[2][2][4][2], const Unit& u, int wr, int wc, int fr, int fq) const {
        typedef unsigned u32x2 __attribute__((ext_vector_type(2)));
        const int row0 = (u.pm - pm_off) * BM + wr * 64 + fr, col0 = u.pn * BM + wc * 32 + 8 * fq;
#pragma unroll
        for (int ai = 0; ai < 2; ++ai)
#pragma unroll
            for (int m = 0; m < 4; ++m) { GAS unsigned char* rowp = O + (size_t)(row0 + ai * HALF + m * 16) * ldc + col0;
#pragma unroll
                for (int bj = 0; bj < 2; ++bj) { u32x2 w; w.x = pk4(acc[ai][bj][m][0]); w.y = pk4(acc[ai][bj][m][1]); *(GAS u32x2*)(rowp + bj * HALF) = w; } }
    }
};
struct EpiSwiGLU {
    static constexpr bool PERM = true;
    gbf* O; int ldc; int pm_off;
    __device__ __forceinline__ void operator()(const f32x4 (&acc)[2][2][4][2], const Unit& u, int wr, int wc, int fr, int fq) const {
        const int row0 = (u.pm - pm_off) * BM + wr * 64 + fr, col0 = u.pn * HALF + wc * 32 + 8 * fq;
#pragma unroll
        for (int ai = 0; ai < 2; ++ai)
#pragma unroll
            for (int m = 0; m < 4; ++m) { gbf* rowp = O + (size_t)(row0 + ai * HALF + m * 16) * ldc + col0;
                const f32x4 g0 = acc[ai][0][m][0], g1 = acc[ai][0][m][1], u0 = acc[ai][1][m][0], u1 = acc[ai][1][m][1];
                u32x4 w; w.x = cvt_pk_bf16(silu_f(g0[0]) * u0[0], silu_f(g0[1]) * u0[1]); w.y = cvt_pk_bf16(silu_f(g0[2]) * u0[2], silu_f(g0[3]) * u0[3]);
                w.z = cvt_pk_bf16(silu_f(g1[0]) * u1[0], silu_f(g1[1]) * u1[1]); w.w = cvt_pk_bf16(silu_f(g1[2]) * u1[2], silu_f(g1[3]) * u1[3]);
                *(GAS u32x4*)rowp = w; }
    }
};

struct EpiStoreq {
    static constexpr bool PERM = true;
    gbf* O; int ldc; int pm_off; const GAS float* sa; const GAS float* sw;
    __device__ __forceinline__ void operator()(const f32x4 (&acc)[2][2][4][2], const Unit& u, int wr, int wc, int fr, int fq) const {
        const int row0 = (u.pm - pm_off) * BM + wr * 64 + fr, col0 = u.pn * BM + wc * 32 + 8 * fq;
        f32x4 sc[2][2];
#pragma unroll
        for (int bj = 0; bj < 2; ++bj)
#pragma unroll
            for (int n = 0; n < 2; ++n) sc[bj][n] = *(const GAS f32x4*)(sw + col0 + bj * HALF + 4 * n);
        float sar[2][4];
#pragma unroll
        for (int ai = 0; ai < 2; ++ai)
#pragma unroll
            for (int m = 0; m < 4; ++m) sar[ai][m] = sa[row0 + ai * HALF + m * 16];
#pragma unroll
        for (int ai = 0; ai < 2; ++ai)
#pragma unroll
            for (int m = 0; m < 4; ++m) { gbf* rowp = O + (size_t)(row0 + ai * HALF + m * 16) * ldc + col0; const float sr = sar[ai][m];
#pragma unroll
                for (int bj = 0; bj < 2; ++bj) { const i32x4v i0 = __builtin_bit_cast(i32x4v, acc[ai][bj][m][0]), i1 = __builtin_bit_cast(i32x4v, acc[ai][bj][m][1]);
                    f32x4 v0, v1;
#pragma unroll
                    for (int j = 0; j < 4; ++j) { v0[j] = (float)i0[j] * (sr * sc[bj][0][j]); v1[j] = (float)i1[j] * (sr * sc[bj][1][j]); }
                    u32x4 w; w.x = cvt_pk_bf16(v0[0], v0[1]); w.y = cvt_pk_bf16(v0[2], v0[3]); w.z = cvt_pk_bf16(v1[0], v1[1]); w.w = cvt_pk_bf16(v1[2], v1[3]);
                    *(GAS u32x4*)(rowp + bj * HALF) = w; } }
    }
};
struct EpiSwiGLUq {
    static constexpr bool PERM = true;
    gbf* O; int ldc; int pm_off; const GAS float* sa; const GAS float* sw;
    __device__ __forceinline__ void operator()(const f32x4 (&acc)[2][2][4][2], const Unit& u, int wr, int wc, int fr, int fq) const {
        const int row0 = (u.pm - pm_off) * BM + wr * 64 + fr, col0 = u.pn * HALF + wc * 32 + 8 * fq, bcol0 = u.pn * BM + wc * 32 + 8 * fq;
        const f32x4 sg0 = *(const GAS f32x4*)(sw + bcol0), sg1 = *(const GAS f32x4*)(sw + bcol0 + 4), su0 = *(const GAS f32x4*)(sw + bcol0 + HALF), su1 = *(const GAS f32x4*)(sw + bcol0 + HALF + 4);
        float sar[2][4];
#pragma unroll
        for (int ai = 0; ai < 2; ++ai)
#pragma unroll
            for (int m = 0; m < 4; ++m) sar[ai][m] = sa[row0 + ai * HALF + m * 16];
#pragma unroll
        for (int ai = 0; ai < 2; ++ai)
#pragma unroll
            for (int m = 0; m < 4; ++m) { gbf* rowp = O + (size_t)(row0 + ai * HALF + m * 16) * ldc + col0; const float sr = sar[ai][m];
                const i32x4v ig0 = __builtin_bit_cast(i32x4v, acc[ai][0][m][0]), ig1 = __builtin_bit_cast(i32x4v, acc[ai][0][m][1]), iu0 = __builtin_bit_cast(i32x4v, acc[ai][1][m][0]), iu1 = __builtin_bit_cast(i32x4v, acc[ai][1][m][1]);
                f32x4 g0, g1, u0, u1;
#pragma unroll
                for (int j = 0; j < 4; ++j) { g0[j] = (float)ig0[j] * (sr * sg0[j]); g1[j] = (float)ig1[j] * (sr * sg1[j]); u0[j] = (float)iu0[j] * (sr * su0[j]); u1[j] = (float)iu1[j] * (sr * su1[j]); }
                u32x4 w; w.x = cvt_pk_bf16(silu_f(g0[0]) * u0[0], silu_f(g0[1]) * u0[1]); w.y = cvt_pk_bf16(silu_f(g0[2]) * u0[2], silu_f(g0[3]) * u0[3]);
                w.z = cvt_pk_bf16(silu_f(g1[0]) * u1[0], silu_f(g1[1]) * u1[1]); w.w = cvt_pk_bf16(silu_f(g1[2]) * u1[2], silu_f(g1[3]) * u1[3]);
                __builtin_nontemporal_store(w, (GAS u32x4*)rowp); }
    }
};
struct EpiSwiGLUq8 {
    static constexpr bool PERM = true;
    GAS unsigned char* O; int ldc; int pm_off; const GAS float* sa; const GAS float* sw; float oscale;
    __device__ __forceinline__ unsigned pk4(float a, float b, float c, float d) const {
        a = __builtin_amdgcn_fmed3f(a * oscale, -448.f, 448.f); b = __builtin_amdgcn_fmed3f(b * oscale, -448.f, 448.f); c = __builtin_amdgcn_fmed3f(c * oscale, -448.f, 448.f); d = __builtin_amdgcn_fmed3f(d * oscale, -448.f, 448.f);
        int w = __builtin_amdgcn_cvt_pk_fp8_f32(a, b, 0, false); w = __builtin_amdgcn_cvt_pk_fp8_f32(c, d, w, true); return (unsigned)w; }
    __device__ __forceinline__ void operator()(const f32x4 (&acc)[2][2][4][2], const Unit& u, int wr, int wc, int fr, int fq) const {
        typedef unsigned u32x2 __attribute__((ext_vector_type(2)));
        const int row0 = (u.pm - pm_off) * BM + wr * 64 + fr, col0 = u.pn * HALF + wc * 32 + 8 * fq, bcol0 = u.pn * BM + wc * 32 + 8 * fq;
        const f32x4 sg0 = *(const GAS f32x4*)(sw + bcol0), sg1 = *(const GAS f32x4*)(sw + bcol0 + 4), su0 = *(const GAS f32x4*)(sw + bcol0 + HALF), su1 = *(const GAS f32x4*)(sw + bcol0 + HALF + 4);
        float sar[2][4];
#pragma unroll
        for (int ai = 0; ai < 2; ++ai)
#pragma unroll
            for (int m = 0; m < 4; ++m) sar[ai][m] = sa[row0 + ai * HALF + m * 16];
#pragma unroll
        for (int ai = 0; ai < 2; ++ai)
#pragma unroll
            for (int m = 0; m < 4; ++m) { GAS unsigned char* rowp = O + (size_t)(row0 + ai * HALF + m * 16) * ldc + col0; const float sr = sar[ai][m];
                const i32x4v ig0 = __builtin_bit_cast(i32x4v, acc[ai][0][m][0]), ig1 = __builtin_bit_cast(i32x4v, acc[ai][0][m][1]), iu0 = __builtin_bit_cast(i32x4v, acc[ai][1][m][0]), iu1 = __builtin_bit_cast(i32x4v, acc[ai][1][m][1]);
                f32x4 g0, g1, u0, u1;
#pragma unroll
                for (int j = 0; j < 4; ++j) { g0[j] = (float)ig0[j] * (sr * sg0[j]); g1[j] = (float)ig1[j] * (sr * sg1[j]); u0[j] = (float)iu0[j] * (sr * su0[j]); u1[j] = (float)iu1[j] * (sr * su1[j]); }
                u32x2 w; w.x = pk4(silu_f(g0[0]) * u0[0], silu_f(g0[1]) * u0[1], silu_f(g0[2]) * u0[2], silu_f(g0[3]) * u0[3]);
                w.y = pk4(silu_f(g1[0]) * u1[0], silu_f(g1[1]) * u1[1], silu_f(g1[2]) * u1[2], silu_f(g1[3]) * u1[3]);
                *(GAS u32x2*)rowp = w; }
    }
};
struct EpiSwiGLU8p {
    static constexpr bool PERM = true;
    GAS unsigned char* O; GAS unsigned char* O1; int split; int ldc;
    __device__ __forceinline__ float h1(float t, float u) const { return __builtin_amdgcn_fmed3f((t * u) * __builtin_amdgcn_rcpf(1.0f + __builtin_amdgcn_exp2f(t)), -448.f, 448.f); }
    __device__ __forceinline__ unsigned pk4(float a, float b, float c, float d) const { int w = __builtin_amdgcn_cvt_pk_fp8_f32(a, b, 0, false); w = __builtin_amdgcn_cvt_pk_fp8_f32(c, d, w, true); return (unsigned)w; }
    __device__ __forceinline__ void operator()(const f32x4 (&acc)[2][2][4][2], const Unit& u, int wr, int wc, int fr, int fq) const {
        typedef unsigned u32x2 __attribute__((ext_vector_type(2)));
        GAS unsigned char* Ob = u.pm < split ? O : O1;
        const int row0 = (u.pm < split ? u.pm : u.pm - split) * BM + wr * 64 + fr, col0 = u.pn * HALF + wc * 32 + 8 * fq;
#pragma unroll
        for (int ai = 0; ai < 2; ++ai)
#pragma unroll
            for (int m = 0; m < 4; ++m) { GAS unsigned char* rowp = Ob + (size_t)(row0 + ai * HALF + m * 16) * ldc + col0;
                const f32x4 g0 = acc[ai][0][m][0], g1 = acc[ai][0][m][1], u0 = acc[ai][1][m][0], u1 = acc[ai][1][m][1];
                u32x2 w; w.x = pk4(h1(g0[0], u0[0]), h1(g0[1], u0[1]), h1(g0[2], u0[2]), h1(g0[3], u0[3]));
                w.y = pk4(h1(g1[0], u1[0]), h1(g1[1], u1[1]), h1(g1[2], u1[2]), h1(g1[3], u1[3]));
                __builtin_nontemporal_store(w, (GAS u32x2*)rowp); }
    }
};
struct EpiSwiGLU8 {
    static constexpr bool PERM = true;
    GAS unsigned char* O; GAS unsigned char* O1; int split; int ldc; float oscale;
    __device__ __forceinline__ unsigned pk4(float a, float b, float c, float d) const {
        a = __builtin_amdgcn_fmed3f(a * oscale, -448.f, 448.f); b = __builtin_amdgcn_fmed3f(b * oscale, -448.f, 448.f); c = __builtin_amdgcn_fmed3f(c * oscale, -448.f, 448.f); d = __builtin_amdgcn_fmed3f(d * oscale, -448.f, 448.f);
        int w = __builtin_amdgcn_cvt_pk_fp8_f32(a, b, 0, false); w = __builtin_amdgcn_cvt_pk_fp8_f32(c, d, w, true); return (unsigned)w; }
    __device__ __forceinline__ void operator()(const f32x4 (&acc)[2][2][4][2], const Unit& u, int wr, int wc, int fr, int fq) const {
        typedef unsigned u32x2 __attribute__((ext_vector_type(2)));
        GAS unsigned char* Ob = u.pm < split ? O : O1;
        const int row0 = (u.pm < split ? u.pm : u.pm - split) * BM + wr * 64 + fr, col0 = u.pn * HALF + wc * 32 + 8 * fq;
#pragma unroll
        for (int ai = 0; ai < 2; ++ai)
#pragma unroll
            for (int m = 0; m < 4; ++m) { GAS unsigned char* rowp = Ob + (size_t)(row0 + ai * HALF + m * 16) * ldc + col0;
                const f32x4 g0 = acc[ai][0][m][0], g1 = acc[ai][0][m][1], u0 = acc[ai][1][m][0], u1 = acc[ai][1][m][1];
                u32x2 w; w.x = pk4(silu_f(g0[0]) * u0[0], silu_f(g0[1]) * u0[1], silu_f(g0[2]) * u0[2], silu_f(g0[3]) * u0[3]);
                w.y = pk4(silu_f(g1[0]) * u1[0], silu_f(g1[1]) * u1[1], silu_f(g1[2]) * u1[2], silu_f(g1[3]) * u1[3]);
                __builtin_nontemporal_store(w, (GAS u32x2*)rowp); }
    }
};

typedef int i32x8 __attribute__((ext_vector_type(8))); typedef int i32x4v __attribute__((ext_vector_type(4))); typedef int i32x6 __attribute__((ext_vector_type(6))); typedef int i32x2v __attribute__((ext_vector_type(2)));
__device__ __forceinline__ i32x6 cat6(i32x4v x, i32x2v y) { return __builtin_shufflevector(__builtin_shufflevector(x, x, 0, 1, 2, 3, -1, -1), __builtin_shufflevector(y, y, 0, 1, -1, -1, -1, -1), 0, 1, 2, 3, 6, 7); }
__device__ __forceinline__ i32x8 cat8(bf16x8 a, bf16x8 b) { const i32x4v x = __builtin_bit_cast(i32x4v, a), y = __builtin_bit_cast(i32x4v, b); return __builtin_shufflevector(x, y, 0, 1, 2, 3, 4, 5, 6, 7); }
template <class Epi, class Sched, bool GATHER, int MODE = 0  >
__device__ __forceinline__ void gemm_phase(LAS unsigned char* lds, const Gemm g, const Sched& S, const Epi& E) {
    int tid_ = threadIdx.x; asm volatile("" : "+v"(tid_));
    const int tid = tid_, wid = __builtin_amdgcn_readfirstlane(tid >> 6), lane = tid & 63, wr = wid >> 2, wc = wid & 3, fr = lane & 15, fq = lane >> 4;
    int K_ = g.K; asm volatile("" : "+s"(K_));
    const int K = K_, nt = g.nt ? g.nt : K / BK;
    unsigned voffB[2]; int Rr[2], Cc[2];
#pragma unroll
    for (int i = 0; i < 2; ++i) { int R, C; stage_rc(tid * 16 + i * 8192, R, C); const int Rb = Epi::PERM ? ((R & ~31) + perm32(R & 31)) : R;
        voffB[i] = (unsigned)(Rb * K + C) * 2u; Rr[i] = R; Cc[i] = C; }
    const size_t kstep = (size_t)(BK * 2);
    const size_t hstep = (size_t)HALF * K * 2;
    const unsigned ldsw = (unsigned)wid * 1024u;
    const int aoff = lds_byte(wr * 64 + fr, fq * 8), boff = lds_byte(wc * 32 + fr, fq * 8);
#define PG8_SA(b, h) (((b) * 2 + (h)) * HTB)
#define PG8_SB(b, h) ((4 + (b) * 2 + (h)) * HTB)
#define PG8_STAGE(bufoff, gbase, voff) do { _Pragma("unroll") for (int _i = 0; _i < 2; ++_i) \
        __builtin_amdgcn_global_load_lds((const GAS unsigned*)((gcp)(gbase) + (voff)[_i]), (LAS unsigned*)(lds + (bufoff) + ldsw + _i * 8192), 16, 0, 0); } while (0)
#define PG8_LDA(dst, b, h) do { _Pragma("unroll") for (int m = 0; m < 4; ++m) { if constexpr (MODE == 0 || MODE == 2) { _Pragma("unroll") for (int k = 0; k < 2; ++k) dst[m][k] = *(const LAS bf16x8*)(lds + PG8_SA(b, h) + aoff + m * 2048 + k * 1024); } \
        else if constexpr (MODE == 1) dst##8[m] = cat8(*(const LAS bf16x8*)(lds + PG8_SA(b, h) + aoff + m * 2048), *(const LAS bf16x8*)(lds + PG8_SA(b, h) + aoff + m * 2048 + 1024)); \
        else dst##6[m] = cat6(*(const LAS i32x4v*)(lds + PG8_SA(b, h) + aoff + m * 2048), *(const volatile LAS i32x2v*)(lds + PG8_SA(b, h) + aoff + m * 2048 + 1024)); } } while (0)
#define PG8_LDB(dst, b, h) do { _Pragma("unroll") for (int n = 0; n < 2; ++n) { if constexpr (MODE == 0 || MODE == 2) { _Pragma("unroll") for (int k = 0; k < 2; ++k) dst[n][k] = *(const LAS bf16x8*)(lds + PG8_SB(b, h) + boff + n * 2048 + k * 1024); } \
        else if constexpr (MODE == 1) dst##8[n] = cat8(*(const LAS bf16x8*)(lds + PG8_SB(b, h) + boff + n * 2048), *(const LAS bf16x8*)(lds + PG8_SB(b, h) + boff + n * 2048 + 1024)); \
        else dst##6[n] = cat6(*(const LAS i32x4v*)(lds + PG8_SB(b, h) + boff + n * 2048), *(const volatile LAS i32x2v*)(lds + PG8_SB(b, h) + boff + n * 2048 + 1024)); } } while (0)
#define PG8_MMA(ai, bj, At, Bt) do { __builtin_amdgcn_s_setprio(1); _Pragma("unroll") for (int m = 0; m < 4; ++m) _Pragma("unroll") for (int n = 0; n < 2; ++n) { \
        if constexpr (MODE == 0) { _Pragma("unroll") for (int k = 0; k < 2; ++k) acc[ai][bj][m][n] = __builtin_amdgcn_mfma_f32_16x16x32_bf16(Bt[n][k], At[m][k], acc[ai][bj][m][n], 0, 0, 0); } \
        else if constexpr (MODE == 2) { _Pragma("unroll") for (int k = 0; k < 2; ++k) acc[ai][bj][m][n] = __builtin_bit_cast(f32x4, __builtin_amdgcn_mfma_i32_16x16x64_i8(__builtin_bit_cast(i32x4v, Bt[n][k]), __builtin_bit_cast(i32x4v, At[m][k]), __builtin_bit_cast(i32x4v, acc[ai][bj][m][n]), 0, 0, 0)); } \
        else if constexpr (MODE == 1) asm volatile("v_mfma_scale_f32_16x16x128_f8f6f4 %0, %1, %2, %0, %3, %4 op_sel_hi:[0,0,0]" : "+v"(acc[ai][bj][m][n]) : "v"(Bt##8[n]), "v"(At##8[m]), "v"(vsb), "v"(vsa)); \
        else asm volatile("v_mfma_scale_f32_16x16x128_f8f6f4 %0, %1, %2, %0, %3, %4 op_sel_hi:[0,0,0] cbsz:2 blgp:2" : "+v"(acc[ai][bj][m][n]) : "v"(Bt##6[n]), "v"(At##6[m]), "v"((bj) ? vsb1 : vsb), "v"(vsa)); } \
        __builtin_amdgcn_s_setprio(0); } while (0)
#define PG8_MMA0(ai, bj, At, Bt) do { __builtin_amdgcn_s_setprio(1); _Pragma("unroll") for (int m = 0; m < 4; ++m) _Pragma("unroll") for (int n = 0; n < 2; ++n) { \
        if constexpr (MODE == 0) { acc[ai][bj][m][n] = __builtin_amdgcn_mfma_f32_16x16x32_bf16(Bt[n][0], At[m][0], (f32x4){0.f, 0.f, 0.f, 0.f}, 0, 0, 0); \
                                   acc[ai][bj][m][n] = __builtin_amdgcn_mfma_f32_16x16x32_bf16(Bt[n][1], At[m][1], acc[ai][bj][m][n], 0, 0, 0); } \
        else if constexpr (MODE == 1) asm volatile("v_mfma_scale_f32_16x16x128_f8f6f4 %0, %1, %2, 0, %3, %4 op_sel_hi:[0,0,0]" : "=&v"(acc[ai][bj][m][n]) : "v"(Bt##8[n]), "v"(At##8[m]), "v"(vsb), "v"(vsa)); \
        else asm volatile("v_mfma_scale_f32_16x16x128_f8f6f4 %0, %1, %2, 0, %3, %4 op_sel_hi:[0,0,0] cbsz:2 blgp:2" : "=&v"(acc[ai][bj][m][n]) : "v"(Bt##6[n]), "v"(At##6[m]), "v"((bj) ? vsb1 : vsb), "v"(vsa)); } \
        __builtin_amdgcn_s_setprio(0); } while (0)
#define PG8_WAIT_V(n) asm volatile("s_waitcnt vmcnt(" #n ")" ::: "memory")
#define PG8_WAIT_L(n) asm volatile("s_waitcnt lgkmcnt(" #n ")" ::: "memory")
#define PG8_BAR __builtin_amdgcn_s_barrier()
#define PG8_SCHED __builtin_amdgcn_sched_barrier(0)
#define PG8_AOFF(v, ui_) do { _Pragma("unroll") for (int _h = 0; _h < 2; ++_h) _Pragma("unroll") for (int _i = 0; _i < 2; ++_i) { \
        const int _row = S.row(ui_, _h * HALF + Rr[_i]); v[_h][_i] = (unsigned)(_row * K + Cc[_i]) * 2u; } } while (0)
#define PG8_STA(bufoff, kbase, h, vv) do { if constexpr (GATHER) { PG8_STAGE(bufoff, kbase, vv[h]); } else { PG8_STAGE(bufoff, (kbase) + (h) * hstep, voffA); } } while (0)
    Unit cur, nxt; int ui = 0;
    if (!S.next(0, cur)) return;
    f32x4 acc[2][2][4][2];
    if constexpr (MODE == 0 || MODE == 2) {
#pragma unroll
        for (int a = 0; a < 2; ++a)
#pragma unroll
            for (int b = 0; b < 2; ++b)
#pragma unroll
                for (int m = 0; m < 4; ++m)
#pragma unroll
                    for (int n = 0; n < 2; ++n) acc[a][b][m][n] = (f32x4){0.f, 0.f, 0.f, 0.f}; }
    bf16x8 At[4][2], B0[2][2], B1[2][2]; i32x8 At8[4], B08[2], B18[2]; i32x6 At6[4], B06[2], B16[2];
    unsigned voffA[2], vc[2][2];
    int vsa = (int)g.sa, vsb = (int)g.sb, vsb1 = (int)(g.sb1 ? g.sb1 : g.sb); if constexpr (MODE == 1 || MODE == 3) asm volatile("" : "+v"(vsa), "+v"(vsb), "+v"(vsb1));
#pragma unroll
    for (int i = 0; i < 2; ++i) voffA[i] = (unsigned)(Rr[i] * K + Cc[i]) * 2u;
    if constexpr (GATHER) PG8_AOFF(vc, 0);
    gcp cA = GATHER ? (gcp)g.A : S.a_base(g, cur); gcp cB = S.b_base(g, cur);
    PG8_STAGE(PG8_SB(0, 0), cB, voffB); PG8_STAGE(PG8_SB(0, 1), cB + hstep, voffB); PG8_STA(PG8_SA(0, 0), cA, 0, vc); PG8_STA(PG8_SA(0, 1), cA, 1, vc);
    if (wr == 1) PG8_BAR;
    PG8_WAIT_V(2); PG8_BAR;
    PG8_STAGE(PG8_SB(1, 0), cB + kstep, voffB); PG8_STAGE(PG8_SB(1, 1), cB + hstep + kstep, voffB);
    PG8_WAIT_V(4); PG8_BAR;
    for (;;) {
        const bool has_next = S.next(ui + 1, nxt);
        gcp nA = cA; gcp nB = cB;
        if (has_next) { nA = GATHER ? (gcp)g.A : S.a_base(g, nxt); nB = S.b_base(g, nxt); }
#define PG8_BODY(MMAF) { \
            const bool last = (t == nt - 2); \
            gcp a1 = cA + (size_t)(t + 1) * kstep; \
            gcp a2 = last ? nA : cA + (size_t)(t + 2) * kstep; gcp b2 = last ? nB : cB + (size_t)(t + 2) * kstep; \
            gcp b3 = b2 + kstep; \
            unsigned w2[2][2]; \
            if constexpr (GATHER) { \
                _Pragma("unroll") for (int h = 0; h < 2; ++h) _Pragma("unroll") for (int i = 0; i < 2; ++i) w2[h][i] = vc[h][i]; \
                if (last) { PG8_AOFF(w2, has_next ? ui + 1 : ui); } }                      \
              \
            PG8_LDB(B0, 0, 0); PG8_LDB(B1, 0, 1); PG8_SCHED; PG8_LDA(At, 0, 0); PG8_STA(PG8_SA(1, 0), a1, 0, vc); PG8_STA(PG8_SA(1, 1), a1, 1, vc); \
            PG8_WAIT_V(8); PG8_WAIT_L(0); PG8_BAR; MMAF(0, 0, At, B0); MMAF(0, 1, At, B1); PG8_BAR; PG8_SCHED; \
              \
            PG8_LDA(At, 0, 1); PG8_STAGE(PG8_SB(0, 0), b2, voffB); PG8_STAGE(PG8_SB(0, 1), b2 + hstep, voffB); \
            PG8_WAIT_V(6); PG8_WAIT_L(0); PG8_BAR; MMAF(1, 0, At, B0); MMAF(1, 1, At, B1); PG8_BAR; PG8_SCHED; \
              \
            PG8_LDB(B0, 1, 0); PG8_LDB(B1, 1, 1); PG8_SCHED; PG8_LDA(At, 1, 0); PG8_STA(PG8_SA(0, 0), a2, 0, w2); PG8_STA(PG8_SA(0, 1), a2, 1, w2); \
            PG8_WAIT_V(8); PG8_WAIT_L(0); PG8_BAR; PG8_MMA(0, 0, At, B0); PG8_MMA(0, 1, At, B1); PG8_BAR; PG8_SCHED; \
              \
            PG8_LDA(At, 1, 1); PG8_STAGE(PG8_SB(1, 0), b3, voffB); PG8_STAGE(PG8_SB(1, 1), b3 + hstep, voffB); \
            PG8_WAIT_V(6); PG8_WAIT_L(0); PG8_BAR; PG8_MMA(1, 0, At, B0); PG8_MMA(1, 1, At, B1); PG8_BAR; PG8_SCHED; }
        if constexpr (MODE == 1 || MODE == 3) {
            { const int t = 0; PG8_BODY(PG8_MMA0) }
#pragma unroll 1
            for (int t = 2; t < nt; t += 2) PG8_BODY(PG8_MMA)
        } else {
#pragma unroll 1
            for (int t = 0; t < nt; t += 2) PG8_BODY(PG8_MMA)
        }
        if (wr == 0) PG8_BAR;
        if constexpr (MODE == 1 || MODE == 3) asm volatile("s_nop 15\n\ts_nop 15" ::: "memory");
        E(acc, cur, wr, wc, fr, fq);
        if (!has_next) break;
        if constexpr (MODE == 0 || MODE == 2) {
#pragma unroll
            for (int a = 0; a < 2; ++a)
#pragma unroll
                for (int b = 0; b < 2; ++b)
#pragma unroll
                    for (int m = 0; m < 4; ++m)
#pragma unroll
                        for (int n = 0; n < 2; ++n) acc[a][b][m][n] = (f32x4){0.f, 0.f, 0.f, 0.f}; }
        cur = nxt; cA = nA; cB = nB; ++ui;
        if constexpr (GATHER) PG8_AOFF(vc, ui);
        if (wr == 1) PG8_BAR;
    }
    PG8_WAIT_V(0);
    PG8_BAR;
#undef PG8_SA
#undef PG8_SB
#undef PG8_STAGE
#undef PG8_LDA
#undef PG8_LDB
#undef PG8_MMA
#undef PG8_WAIT_V
#undef PG8_WAIT_L
#undef PG8_BAR
#undef PG8_SCHED
#undef PG8_AOFF
#undef PG8_BODY
#undef PG8_MMA0
#undef PG8_STA
}
}

constexpr size_t MiB = 1u << 20;
constexpr size_t WS_CTL = 0, CTL_ZERO_BYTES = 1 * MiB;
constexpr size_t WS_TOKINFO = 2 * MiB;
constexpr size_t WS_SW = 2 * MiB + 512 * 1024;
constexpr size_t WS_SWIN = 2 * MiB + 544 * 1024;
constexpr size_t WS_SA = 2 * MiB + 576 * 1024;
constexpr size_t WS_INV = 3 * MiB;
constexpr size_t WS_WIN = 4 * MiB;
constexpr size_t WS_WOUT = 11 * MiB;
constexpr size_t WS_WGU = 15 * MiB;
constexpr size_t WS_WD = 26 * MiB;
constexpr size_t WS_SGUW = 31 * MiB + 512 * 1024;
constexpr size_t WS_MWGU = 32 * MiB;
constexpr size_t WS_FSP = 88 * MiB;
constexpr size_t WS_MWD = 116 * MiB;
constexpr size_t WS_H16 = 144 * MiB;
constexpr size_t WS_XN = 208 * MiB;
constexpr size_t WS_HIDC = 240 * MiB;
constexpr size_t WS_Z = 272 * MiB;
constexpr size_t WS_MERGED = 384 * MiB;
constexpr size_t WS_HID = 272 * MiB;
constexpr size_t WS_FS = 360 * MiB;
constexpr size_t WS_END = 492 * MiB;
constexpr size_t OUT_MIX = 0, OUT_ROPE = 64 * MiB;
constexpr int CW_BAR = 4096;
constexpr int CW_CM = 32768;
constexpr int CW_CM2 = CW_CM + 2 * FFD;
constexpr int CW_CNT = 16384;

constexpr int RING_BYTES = 131072;
constexpr int P2_K = 0, P2_KSTRIDE = 272, P2_V = 256 * P2_KSTRIDE, P2_SSQ = 2 * 256 * P2_KSTRIDE;
constexpr int P2_BYTES = P2_SSQ + 8192;
constexpr int ROWTAB_OFF = 139264, ROWTAB_UNITS = 32;
constexpr int LDSCTL_OFF = 155648, MISC_OFF = LDSCTL_OFF + 320, MOETBL_OFF = LDSCTL_OFF + 512;
constexpr int ROUTE_OFF = LDSCTL_OFF + 1024;
constexpr int LDS_BYTES = 159744;
static_assert(P2_BYTES <= LDSCTL_OFF && ROWTAB_OFF + ROWTAB_UNITS * 512 <= LDSCTL_OFF && ROUTE_OFF + 1024 <= LDS_BYTES && LDS_BYTES <= 163840, "LDS map");

typedef unsigned short bf16;
typedef unsigned v4u __attribute__((ext_vector_type(4)));
typedef unsigned v2u __attribute__((ext_vector_type(2)));
typedef float f32x4 __attribute__((ext_vector_type(4)));
typedef GAS unsigned gu32;
#define RLX_AGENT __ATOMIC_RELAXED, __HIP_MEMORY_SCOPE_AGENT
#define LDS_WAIT() asm volatile("s_waitcnt lgkmcnt(0)" ::: "memory")
#define VM_WAIT() asm volatile("s_waitcnt vmcnt(0)" ::: "memory")
__device__ __forceinline__ unsigned f2bf(float f) { unsigned u = __builtin_bit_cast(unsigned, f); return (u + 0x7fffu + ((u >> 16) & 1u)) >> 16; }
__device__ __forceinline__ unsigned pk2(float lo, float hi) { return f2bf(lo) | (f2bf(hi) << 16); }
__device__ __forceinline__ float bflo(unsigned w) { return __uint_as_float(w << 16); }
__device__ __forceinline__ float bfhi(unsigned w) { return __uint_as_float(w & 0xffff0000u); }

#define XB_TMO      128
#define XB_XCNT(j)  (256  + 64 * (j))
#define XB_XSUB(j)  (1280 + 64 * (j))
#define XB_XGEN(j)  (2304 + 64 * (j))
#define XB_TOP      3328
#define XB_TOPGEN   3392
#define XCD_BAR_WORDS 3456
#define XB_SPIN_CAP (1u << 18)

__device__ __forceinline__ unsigned xb_ld(unsigned* p)              { return __hip_atomic_load(p, __ATOMIC_RELAXED, __HIP_MEMORY_SCOPE_AGENT); }
__device__ __forceinline__ unsigned xb_add(unsigned* p, unsigned v) { return __hip_atomic_fetch_add(p, v, __ATOMIC_RELAXED, __HIP_MEMORY_SCOPE_AGENT); }
__device__ __forceinline__ unsigned xb_xcc_id() { return (unsigned)__builtin_amdgcn_s_getreg((3 << 11) | 20) & 0xFu; }
#define XB_SPIN(cond, bar) do { unsigned _sp = 0; while (cond) { __builtin_amdgcn_s_sleep(1); \
    if ((++_sp & 255u) == 0u) { if (xb_ld(&(bar)[XB_TMO])) break; if (_sp > XB_SPIN_CAP) { atomicAdd(&(bar)[XB_TMO], 1u); break; } } } } while (0)

struct XcdBarrier { unsigned* bar; unsigned x; volatile LAS unsigned* st; };

__device__ __forceinline__ XcdBarrier xcd_barrier_post(unsigned* bar, volatile LAS unsigned* st) {
    XcdBarrier b; b.bar = bar; b.x = xb_xcc_id(); b.st = st;
    if (threadIdx.x == 0) (void)xb_add(&bar[XB_XCNT(b.x)], 1u);
    return b;
}
__device__ __forceinline__ void xcd_barrier_complete(unsigned* bar, unsigned x, unsigned& nloc, unsigned& nx) {
    const unsigned G = gridDim.x * gridDim.y * gridDim.z;
    unsigned sum, cnt, mine, sp = 0u;
    for (;;) {
        sum = 0u; cnt = 0u; mine = 0u;
#pragma unroll
        for (unsigned j = 0; j < 16; ++j) { const unsigned c = xb_ld(&bar[XB_XCNT(j)]); sum += c; cnt += (c > 0u) ? 1u : 0u; mine = (j == x) ? c : mine; }
        if (sum == G) break;
        __builtin_amdgcn_s_sleep(1);
        if ((++sp & 255u) == 0u) { if (xb_ld(&bar[XB_TMO])) break; if (sp > XB_SPIN_CAP) { atomicAdd(&bar[XB_TMO], 1u); break; } }
    }
    nloc = mine > 0u ? mine : 1u; nx = cnt > 0u ? cnt : 1u;
}
__device__ __forceinline__ void xcd_barrier(const XcdBarrier& b) {
    asm volatile("s_waitcnt vmcnt(0)" ::: "memory");
    __syncthreads();
    if (threadIdx.x == 0) {
        unsigned* bar = b.bar;
        __builtin_amdgcn_s_waitcnt(0);
        unsigned nloc = b.st[0], nx = b.st[1];
        if (nloc == 0u) { xcd_barrier_complete(bar, b.x, nloc, nx); b.st[0] = nloc; b.st[1] = nx; }
        const unsigned old = xb_add(&bar[XB_XSUB(b.x)], 1u);
        const unsigned gen = old / nloc;
        if (old + 1u == (gen + 1u) * nloc) {
            __builtin_amdgcn_fence(__ATOMIC_RELEASE, "agent");
            asm volatile("s_waitcnt vmcnt(0)" ::: "memory");
            const unsigned og = xb_add(&bar[XB_TOP], 1u);
            const unsigned tg = og / nx;
            if (og + 1u == (tg + 1u) * nx) xb_add(&bar[XB_TOPGEN], 1u);
            else XB_SPIN(xb_ld(&bar[XB_TOPGEN]) == tg, bar);
            __builtin_amdgcn_fence(__ATOMIC_ACQUIRE, "agent");
            xb_add(&bar[XB_XGEN(b.x)], 1u);
            asm volatile("s_waitcnt vmcnt(0)" ::: "memory");
        } else {
            XB_SPIN(xb_ld(&bar[XB_XGEN(b.x)]) == gen, bar);
            __builtin_amdgcn_fence(__ATOMIC_ACQUIRE, "agent");
            asm volatile("s_waitcnt vmcnt(0)" ::: "memory");
        }
    }
    __syncthreads();
}

struct Args { const void* in[22]; float* out; unsigned char* ws; int ph_lo, ph_hi; };
struct Frame {
    LAS unsigned char* lds;
    int tid, lane, wave, G, bid;
};
constexpr int NWAVES = 8;
constexpr int NR = 4;
__device__ __forceinline__ Frame opaque(const Frame& F0) { Frame F = F0; asm volatile("" : "+s"(F.G), "+s"(F.bid), "+s"(F.wave), "+v"(F.tid)); F.lane = F.tid & 63; return F; }

template <int CTRL> __device__ __forceinline__ float dpp_f(float v) { return __builtin_bit_cast(float, __builtin_amdgcn_update_dpp(0, __builtin_bit_cast(int, v), CTRL, 0xf, 0xf, true)); }
__device__ __forceinline__ float swap16_add(float v) { float a = v, b = v; asm volatile("s_nop 1\n\tv_permlane16_swap_b32 %0, %1" : "+v"(a), "+v"(b)); return a + b; }
__device__ __forceinline__ float swap32_add(float v) { float a = v, b = v; asm volatile("s_nop 1\n\tv_permlane32_swap_b32 %0, %1" : "+v"(a), "+v"(b)); return a + b; }
__device__ __forceinline__ float swap32_max(float v) { float a = v, b = v; asm volatile("s_nop 1\n\tv_permlane32_swap_b32 %0, %1" : "+v"(a), "+v"(b)); return fmaxf(a, b); }
__device__ __forceinline__ unsigned xchg32(unsigned v, int hi) { unsigned a = v, b = v; asm volatile("s_nop 1\n\tv_permlane32_swap_b32 %0, %1" : "+v"(a), "+v"(b)); return hi ? a : b; }
__device__ __forceinline__ void pl32_swap(unsigned& a, unsigned& b) { asm volatile("s_nop 1\n\tv_permlane32_swap_b32 %0, %1" : "+v"(a), "+v"(b)); }
__device__ __forceinline__ void pl32_swap2(v2u& a, v2u& b) { unsigned ax = a.x, ay = a.y, bx = b.x, by = b.y; pl32_swap(ax, bx); pl32_swap(ay, by); a = (v2u){ax, ay}; b = (v2u){bx, by}; }
__device__ __forceinline__ void store_pair16(GAS unsigned char* rowbase16  , int hi, v2u a, v2u b) {
    pl32_swap2(a, b);
    *(GAS v4u*)(rowbase16 + (hi ? 16 : 0)) = (v4u){a.x, a.y, b.x, b.y};
}
__device__ __forceinline__ float xor1_add(float v) { return v + dpp_f<0xB1>(v); }
__device__ __forceinline__ float wave_sum(float v) {
    v += dpp_f<0xB1>(v); v += dpp_f<0x4E>(v); v += dpp_f<0x141>(v); v += dpp_f<0x140>(v);
    v = swap16_add(v); v = swap32_add(v);
    return v;
}
__device__ __forceinline__ float gelu_tanh(float x) {
    const float t = x * __builtin_fmaf(x * x, -1.4426950408889634f * 1.5957691216057308f * 0.044715f, -1.4426950408889634f * 1.5957691216057308f);
    return x * __builtin_amdgcn_rcpf(1.0f + __builtin_amdgcn_exp2f(t));
}

__device__ __forceinline__ void p0_transpose_item(const GAS float* W, int K, int N, GAS bf16* WT, int mode, LAS float* scr, int item, int lane) {
    const int nblk = N / 32, kb = item / nblk, nb = item % nblk, k0 = 64 * kb, n0 = 32 * nb;
    const int d0 = mode == 0 ? n0 : ((n0 >> 7) * 256 + (n0 & 127) + (mode == 2 ? 128 : 0));
    float wv[32];
#pragma unroll
    for (int i = 0; i < 32; ++i) { const int kk = 2 * i + (lane >> 5); wv[i] = __builtin_nontemporal_load(&W[(size_t)(k0 + kk) * N + n0 + (lane & 31)]); }
#pragma unroll
    for (int i = 0; i < 32; ++i) { const int kk = 2 * i + (lane >> 5); scr[kk * 33 + (lane & 31)] = wv[i]; }
    LDS_WAIT(); asm volatile("" ::: "memory");
    const int c = lane & 7;
#pragma unroll
    for (int j = 0; j < 4; ++j) { const int n = (lane >> 3) + 8 * j; const LAS float* s = scr + (8 * c) * 33 + n;
        v4u o; o.x = pk2(s[0 * 33], s[1 * 33]); o.y = pk2(s[2 * 33], s[3 * 33]); o.z = pk2(s[4 * 33], s[5 * 33]); o.w = pk2(s[6 * 33], s[7 * 33]);
        *(GAS v4u*)(WT + (size_t)(d0 + n) * K + k0 + 8 * c) = o; }
    LDS_WAIT(); asm volatile("" ::: "memory");
}

__device__ __forceinline__ unsigned pk4_fp8(float a, float b, float c, float d) { int w = __builtin_amdgcn_cvt_pk_fp8_f32(a, b, 0, false); w = __builtin_amdgcn_cvt_pk_fp8_f32(c, d, w, true); return (unsigned)w; }
__device__ __forceinline__ void store_quad8(GAS unsigned char* rowbase, int hi, const unsigned (&p)[4]) {
    unsigned p0 = p[0], p1 = p[1], p2 = p[2], p3 = p[3];
    pl32_swap(p0, p2); pl32_swap(p1, p3);
    *(GAS v4u*)(rowbase + (hi ? 16 : 0)) = (v4u){p0, p2, p1, p3};
}
__device__ __forceinline__ void p0_transpose_item8(const GAS float* W, int K, int N, GAS unsigned char* WT, int mode, float scale, LAS float* scr, int item, int lane) {
    const int nblk = N / 32, kb = item / nblk, nb = item % nblk, k0 = 64 * kb, n0 = 32 * nb;
    const int d0 = mode == 0 ? n0 : ((n0 >> 7) * 256 + (n0 & 127) + (mode == 2 ? 128 : 0));
    float wv[32];
#pragma unroll
    for (int i = 0; i < 32; ++i) { const int kk = 2 * i + (lane >> 5); wv[i] = __builtin_nontemporal_load(&W[(size_t)(k0 + kk) * N + n0 + (lane & 31)]); }
#pragma unroll
    for (int i = 0; i < 32; ++i) { const int kk = 2 * i + (lane >> 5); scr[kk * 33 + (lane & 31)] = wv[i]; }
    LDS_WAIT(); asm volatile("" ::: "memory");
    const int c = lane & 7;
#pragma unroll
    for (int j = 0; j < 4; ++j) { const int n = (lane >> 3) + 8 * j; const LAS float* sp = scr + (8 * c) * 33 + n;
        v2u o; o.x = pk4_fp8(sp[0 * 33] * scale, sp[1 * 33] * scale, sp[2 * 33] * scale, sp[3 * 33] * scale); o.y = pk4_fp8(sp[4 * 33] * scale, sp[5 * 33] * scale, sp[6 * 33] * scale, sp[7 * 33] * scale);
        __builtin_nontemporal_store(o, (GAS v2u*)(WT + (size_t)(d0 + n) * K + k0 + 8 * c)); }
    LDS_WAIT(); asm volatile("" ::: "memory");
}

typedef float f32x16v __attribute__((ext_vector_type(16))); typedef unsigned v6u __attribute__((ext_vector_type(6)));
__device__ __forceinline__ v6u pk32_fp6(const float (&x)[32]) {
    f32x16v a, b;
#pragma unroll
    for (int i = 0; i < 16; ++i) { a[i] = x[i]; b[i] = x[16 + i]; }
    return __builtin_bit_cast(v6u, __builtin_amdgcn_cvt_scalef32_2xpk16_fp6_f32(a, b, 1.0f));
}
__device__ __forceinline__ void store_f6_group(GAS unsigned char* row, int group  , v6u p) {
    GAS unsigned char* b = row + (group >> 2) * 128 + (group & 3) * 16;
    *(GAS v4u*)b = (v4u){p[0], p[1], p[2], p[3]}; *(GAS v4u*)(b + 64) = (v4u){p[4], p[5], 0u, 0u};
}
__device__ __forceinline__ void p0_transpose_item6(const GAS float* W, int K, int N, GAS unsigned char* WT, int mode, float scale, LAS float* scr, int item, int lane) {
    const int nblk = N / 32, kb = item / nblk, nb = item % nblk, k0 = 64 * kb, n0 = 32 * nb;
    const int d0 = mode == 0 ? n0 : ((n0 >> 7) * 256 + (n0 & 127) + (mode == 2 ? 128 : 0));
    float wv[32];
#pragma unroll
    for (int i = 0; i < 32; ++i) { const int kk = 2 * i + (lane >> 5); wv[i] = __builtin_nontemporal_load(&W[(size_t)(k0 + kk) * N + n0 + (lane & 31)]); }
#pragma unroll
    for (int i = 0; i < 32; ++i) { const int kk = 2 * i + (lane >> 5); scr[kk * 33 + (lane & 31)] = wv[i]; }
    LDS_WAIT(); asm volatile("" ::: "memory");
    const int n = lane & 31, grp = lane >> 5; float x[32];
#pragma unroll
    for (int i = 0; i < 32; ++i) x[i] = scr[(32 * grp + i) * 33 + n] * scale;
    store_f6_group(WT + (size_t)(d0 + n) * K, 2 * kb + grp, pk32_fp6(x));
    LDS_WAIT(); asm volatile("" ::: "memory");
}
__device__ __forceinline__ unsigned pk4_i8(float a, float b, float c, float d, float inv) {
    int q0 = (int)__builtin_rintf(a * inv), q1 = (int)__builtin_rintf(b * inv), q2 = (int)__builtin_rintf(c * inv), q3 = (int)__builtin_rintf(d * inv);
    q0 = q0 < -127 ? -127 : (q0 > 127 ? 127 : q0); q1 = q1 < -127 ? -127 : (q1 > 127 ? 127 : q1); q2 = q2 < -127 ? -127 : (q2 > 127 ? 127 : q2); q3 = q3 < -127 ? -127 : (q3 > 127 ? 127 : q3);
    return ((unsigned)q0 & 255u) | (((unsigned)q1 & 255u) << 8) | (((unsigned)q2 & 255u) << 16) | ((unsigned)q3 << 24);
}
__device__ __forceinline__ void store_row_bf16(GAS bf16* orow, int lane, const f32x4 (&v)[4]) {
    GAS unsigned long long* o8 = (GAS unsigned long long*)orow + lane;
#pragma unroll
    for (int j = 0; j < 4; ++j) o8[64 * j] = (unsigned long long)pk2(v[j].x, v[j].y) | ((unsigned long long)pk2(v[j].z, v[j].w) << 32);
}
__device__ __forceinline__ void load_row_f32(const GAS float* p, int lane, f32x4 (&v)[4]) {
    const GAS f32x4* xr = (const GAS f32x4*)p + lane;
#pragma unroll
    for (int j = 0; j < 4; ++j) v[j] = xr[64 * j];
}
__device__ __forceinline__ void load_row_f32_nt(const GAS float* p, int lane, f32x4 (&v)[4]) {
    const GAS f32x4* xr = (const GAS f32x4*)p + lane;
#pragma unroll
    for (int j = 0; j < 4; ++j) v[j] = __builtin_nontemporal_load(xr + 64 * j);
}
__device__ __forceinline__ void load_row_bf16(const GAS bf16* p, int lane, f32x4 (&v)[4]) {
    const GAS v2u* xr = (const GAS v2u*)p + lane;
#pragma unroll
    for (int j = 0; j < 4; ++j) { const v2u w = xr[64 * j]; v[j] = (f32x4){bflo(w.x), bfhi(w.x), bflo(w.y), bfhi(w.y)}; }
}
template <int N> __device__ __forceinline__ void wave_sum_n(float (&v)[N]) {
#pragma unroll
    for (int q = 0; q < N; ++q) v[q] += dpp_f<0xB1>(v[q]);
#pragma unroll
    for (int q = 0; q < N; ++q) v[q] += dpp_f<0x4E>(v[q]);
#pragma unroll
    for (int q = 0; q < N; ++q) v[q] += dpp_f<0x141>(v[q]);
#pragma unroll
    for (int q = 0; q < N; ++q) v[q] += dpp_f<0x140>(v[q]);
#pragma unroll
    for (int q = 0; q < N; ++q) v[q] = swap16_add(v[q]);
#pragma unroll
    for (int q = 0; q < N; ++q) v[q] = swap32_add(v[q]);
}
__device__ __forceinline__ float row_ssq_local(const f32x4 (&v)[4]) {
    float s = 0.f;
#pragma unroll
    for (int j = 0; j < 4; ++j) s += (v[j].x * v[j].x + v[j].y * v[j].y) + (v[j].z * v[j].z + v[j].w * v[j].w);
    return s;
}
template <int CTRL> __device__ __forceinline__ float dpp_maxf(float v) { return fmaxf(v, dpp_f<CTRL>(v)); }
__device__ __forceinline__ float swap16_max(float v) { float a = v, b = v; asm volatile("s_nop 1\n\tv_permlane16_swap_b32 %0, %1" : "+v"(a), "+v"(b)); return fmaxf(a, b); }
template <int N> __device__ __forceinline__ void wave_max_n(float (&v)[N]) {
#pragma unroll
    for (int q = 0; q < N; ++q) v[q] = dpp_maxf<0xB1>(v[q]);
#pragma unroll
    for (int q = 0; q < N; ++q) v[q] = dpp_maxf<0x4E>(v[q]);
#pragma unroll
    for (int q = 0; q < N; ++q) v[q] = dpp_maxf<0x141>(v[q]);
#pragma unroll
    for (int q = 0; q < N; ++q) v[q] = dpp_maxf<0x140>(v[q]);
#pragma unroll
    for (int q = 0; q < N; ++q) v[q] = swap16_max(v[q]);
#pragma unroll
    for (int q = 0; q < N; ++q) v[q] = swap32_max(v[q]);
}
template <int N> __device__ __forceinline__ void store_rows_i8(GAS unsigned char* base, GAS float* sa, const f32x4 (&hh)[N][4], const int (&mm)[N], const bool (&ok)[N], int lane) {
    float am[N];
#pragma unroll
    for (int q = 0; q < N; ++q) { float m = 0.f;
#pragma unroll
        for (int j = 0; j < 4; ++j) m = fmaxf(fmaxf(m, fmaxf(fabsf(hh[q][j][0]), fabsf(hh[q][j][1]))), fmaxf(fabsf(hh[q][j][2]), fabsf(hh[q][j][3])));
        am[q] = m; }
    wave_max_n<N>(am);
#pragma unroll
    for (int q = 0; q < N; ++q) if (ok[q]) { const float inv = am[q] > 0.f ? 127.0f / am[q] : 0.f;
        GAS unsigned* o4 = (GAS unsigned*)(base + (size_t)mm[q] * D) + lane;
#pragma unroll
        for (int j = 0; j < 4; ++j) o4[64 * j] = pk4_i8(hh[q][j][0], hh[q][j][1], hh[q][j][2], hh[q][j][3], inv);
        if (lane == 0) sa[mm[q]] = am[q] * (1.0f / 127.0f); }
}
typedef _Float16 h16x4 __attribute__((ext_vector_type(4)));
__device__ __forceinline__ void load_row_fp8(const GAS unsigned char* p, int lane, f32x4 (&v)[4]) {
    const GAS unsigned* xr = (const GAS unsigned*)p + lane;
#pragma unroll
    for (int j = 0; j < 4; ++j) { const unsigned w = __builtin_nontemporal_load(xr + 64 * j);
        const auto lo = __builtin_amdgcn_cvt_pk_f32_fp8((int)w, false), hi2 = __builtin_amdgcn_cvt_pk_f32_fp8((int)w, true); v[j] = (f32x4){lo[0], lo[1], hi2[0], hi2[1]}; }
}
__device__ __forceinline__ void load_row_f16(const GAS _Float16* p, int lane, f32x4 (&v)[4]) {
    const GAS h16x4* xr = (const GAS h16x4*)p + lane;
#pragma unroll
    for (int j = 0; j < 4; ++j) { const h16x4 w = __builtin_nontemporal_load(xr + 64 * j); v[j] = (f32x4){(float)w[0], (float)w[1], (float)w[2], (float)w[3]}; }
}
__device__ __forceinline__ void store_row_f16(GAS _Float16* p, int lane, const f32x4 (&v)[4]) {
    GAS h16x4* xr = (GAS h16x4*)p + lane;
#pragma unroll
    for (int j = 0; j < 4; ++j) __builtin_nontemporal_store((h16x4){(_Float16)v[j][0], (_Float16)v[j][1], (_Float16)v[j][2], (_Float16)v[j][3]}, xr + 64 * j);
}
__device__ __forceinline__ float row_ssq(const f32x4 (&v)[4]) {
    float s = 0.f;
#pragma unroll
    for (int j = 0; j < 4; ++j) s += (v[j].x * v[j].x + v[j].y * v[j].y) + (v[j].z * v[j].z + v[j].w * v[j].w);
    return wave_sum(s);
}

#define AS4 __attribute__((address_space(4)))
constexpr int KA_OUT = 22 * 8, KA_WS = 23 * 8, KA_LO = 24 * 8, KA_HI = 24 * 8 + 4;
__device__ __forceinline__ const GAS float* ka_in(int idx) {
    int off = idx * 8; asm volatile("" : "+s"(off));
    const AS4 unsigned char* kp = (const AS4 unsigned char*)__builtin_amdgcn_kernarg_segment_ptr();
    return (const GAS float*)*(const void* const AS4*)(kp + off);
}
__device__ __forceinline__ GAS unsigned char* ka_ptr(int byte_off) {
    int off = byte_off; asm volatile("" : "+s"(off));
    const AS4 unsigned char* kp = (const AS4 unsigned char*)__builtin_amdgcn_kernarg_segment_ptr();
    return (GAS unsigned char*)*(void* const AS4*)(kp + off);
}
__device__ __forceinline__ int ka_int(int byte_off) {
    int off = byte_off; asm volatile("" : "+s"(off));
    const AS4 unsigned char* kp = (const AS4 unsigned char*)__builtin_amdgcn_kernarg_segment_ptr();
    return *(const AS4 int*)(kp + off);
}
typedef GAS bf16 gbf16;
#define WSP(ws, off) ((gbf16*)((ws) + (off)))

__device__ __forceinline__ void moe_table(const Frame& F, GAS unsigned char* ws) {
    LAS int* MOETBL = (LAS int*)(F.lds + MOETBL_OFF);
    __syncthreads();
    if (F.wave == 0) { gu32* ctl = (gu32*)ws; const int ln = F.lane;
        if (ln < NEXP) MOETBL[16 + ln] = (int)__hip_atomic_load(ctl + CW_CNT + 64 * ln, RLX_AGENT);
        asm volatile("s_waitcnt lgkmcnt(0)" ::: "memory");
        if (ln == 0) { int acc_t = 0; MOETBL[0] = 0;
#pragma unroll
            for (int e = 0; e < NEXP; ++e) { acc_t += (MOETBL[16 + e] + 255) >> 8; MOETBL[e + 1] = acc_t; } } }
    __syncthreads();
}

constexpr int I_MG = (D / 64) * (FFE / 32), I_MD = (FFE / 64) * (D / 32), N_MOE_ITEMS = NEXP * (2 * I_MG + I_MD);
constexpr int MOE_DEFER_PER_WAVE = 8;
__device__ __forceinline__ int win_idle_blocks(int G) { const int nu = (T / 256) * (INW / 256), rounds = (nu + G - 1) / G; const int busy = nu - (rounds - 1) * G; return busy < G ? G - busy : 0; }
__device__ __forceinline__ int moe_deferred(int G) { int n = DEPTH * win_idle_blocks(G) * NWAVES * MOE_DEFER_PER_WAVE; return n < N_MOE_ITEMS ? n : N_MOE_ITEMS; }
__device__ __forceinline__ void moe_convert_item(GAS unsigned char* ws, int r, LAS float* scr, int lane) {
    if (r < NEXP * I_MD) { const int e = r / I_MD; p0_transpose_item8(ka_in(21) + (size_t)e * FFE * D, FFE, D, ws + WS_MWD + (size_t)e * D * FFE, 0, MOE_WD_SCALE, scr, r % I_MD, lane); return; } r -= NEXP * I_MD;
    if (r < NEXP * I_MG) { const int e = r / I_MG; p0_transpose_item6(ka_in(19) + (size_t)e * D * FFE, D, FFE, ws + WS_MWGU + (size_t)e * 2 * FFE * D, 1, MOE_WG_SCALE, scr, r % I_MG, lane); return; } r -= NEXP * I_MG;
    { const int e = r / I_MG; p0_transpose_item6(ka_in(20) + (size_t)e * D * FFE, D, FFE, ws + WS_MWGU + (size_t)e * 2 * FFE * D, 2, MOE_WU_SCALE, scr, r % I_MG, lane); }
}

__device__ __forceinline__ void p0_strip_q(const Frame& F, const GAS float* W, int N, GAS unsigned char* WT, int mode, GAS float* sw, int nb) {
    const int lane = F.lane, w = F.wave, n0 = 32 * nb, K = D;
    const int d0 = mode == 0 ? n0 : ((n0 >> 7) * 256 + (n0 & 127) + (mode == 2 ? 128 : 0));
    LAS float* scr = (LAS float*)(F.lds + w * 17408);
    LAS float* cmx = (LAS float*)(F.lds + 8 * 17408);
    float m = 0.f;
#pragma unroll 1
    for (int b = 0; b < 2; ++b) {
        float wv[32];
#pragma unroll
        for (int i = 0; i < 32; ++i) { const int kk = 64 * (2 * w + b) + 2 * i + (lane >> 5); wv[i] = __builtin_nontemporal_load(&W[(size_t)kk * N + n0 + (lane & 31)]); }
#pragma unroll
        for (int i = 0; i < 32; ++i) { const int kk = 2 * i + (lane >> 5); scr[b * 2176 + kk * 33 + (lane & 31)] = wv[i]; m = fmaxf(m, fabsf(wv[i])); }
    }
    m = swap32_max(m);
    if (lane < 32) cmx[w * 32 + lane] = m;
    __syncthreads();
    float inv[4], cmv[4];
#pragma unroll
    for (int j = 0; j < 4; ++j) { const int n = (lane >> 3) + 8 * j; float c = cmx[n];
#pragma unroll
        for (int w2 = 1; w2 < 8; ++w2) c = fmaxf(c, cmx[w2 * 32 + n]);
        cmv[j] = c; inv[j] = c > 0.f ? 127.0f / c : 0.f; }
    const int c8 = lane & 7;
#pragma unroll
    for (int b = 0; b < 2; ++b) { const int k0 = 64 * (2 * w + b);
#pragma unroll
        for (int j = 0; j < 4; ++j) { const int n = (lane >> 3) + 8 * j; const LAS float* sp = scr + b * 2176 + (8 * c8) * 33 + n;
            v2u o; o.x = pk4_i8(sp[0 * 33], sp[1 * 33], sp[2 * 33], sp[3 * 33], inv[j]); o.y = pk4_i8(sp[4 * 33], sp[5 * 33], sp[6 * 33], sp[7 * 33], inv[j]);
            *(GAS v2u*)(WT + (size_t)(d0 + n) * K + k0 + 8 * c8) = o; } }
    if (w == 0 && c8 == 0) {
#pragma unroll
        for (int j = 0; j < 4; ++j) sw[d0 + (lane >> 3) + 8 * j] = cmv[j] * (1.0f / 127.0f); }
    __syncthreads();
}

__device__ __forceinline__ void ph_prologue(const Frame& F_) {
    const Frame F = opaque(F_);
    GAS unsigned char* ws = ka_ptr(KA_WS);
    const int gw = F.bid * NWAVES + F.wave, NGW = F.G * NWAVES;
    LAS float* scr = (LAS float*)(F.lds + F.wave * 16384);
    constexpr int I_OUT = (D / 64) * (D / 32), I_DN = (FFD / 64) * (D / 32);
    constexpr int S_IN = INW / 32, S_G = FFD / 32, N_STRIPS = 2 * S_IN + 2 * S_G;
    for (int st = F.bid; st < N_STRIPS; st += F.G) {
        if (st < 2 * S_IN) { const int l = st / S_IN; p0_strip_q(F, ka_in(3) + (size_t)l * D * INW, INW, ws + WS_WIN + (size_t)l * INW * D, 0, (GAS float*)(ws + WS_SWIN) + l * INW, st % S_IN); }
        else { const int r = st - 2 * S_IN; const GAS float* wg = ka_in(15); const GAS float* wu = ka_in(16);
               p0_strip_q(F, r < S_G ? wg : wu, FFD, ws + WS_WGU, r < S_G ? 1 : 2, (GAS float*)(ws + WS_SW), r % S_G); }
    }
    constexpr int N_DENSE = 2 * I_OUT + I_DN;
    const int ndefer = moe_deferred(F.G);
    const int NITEMS = N_DENSE + N_MOE_ITEMS - ndefer;
    auto do_item = [&](int it) {
        int r = it;
        if (r < 2 * I_OUT) { const int l = r / I_OUT; if (l == 0) p0_transpose_item(ka_in(11), D, D, WSP(ws, WS_WOUT), 0, scr, r % I_OUT, F.lane);
            else p0_transpose_item8(ka_in(11) + (size_t)D * D, D, D, ws + WS_WOUT + (size_t)2 * D * D, 0, WOUT_SCALE, scr, r % I_OUT, F.lane);
            return; } r -= 2 * I_OUT;
        if (r < I_DN) { p0_transpose_item8(ka_in(17), FFD, D, ws + WS_WD, 0, WD_SCALE, scr, r, F.lane); return; } r -= I_DN;
        moe_convert_item(ws, ndefer + r, scr, F.lane);
    };
    const int nx2 = (N_STRIPS > F.G && N_STRIPS - F.G < F.G) ? N_STRIPS - F.G : 0, nw1 = (F.G - nx2) * NWAVES;
    int EX = 2 * nw1; if (EX > NITEMS) EX = 0;
    if (EX > 0 && F.bid >= nx2) { const int w1 = (F.bid - nx2) * NWAVES + F.wave; do_item(w1); do_item(nw1 + w1); }
    for (int it = EX + gw; it < NITEMS; it += NGW) do_item(it);
    { const GAS int* positions = (const GAS int*)ka_in(1); GAS float* rope = (GAS float*)(ka_ptr(KA_OUT) + OUT_ROPE);
      for (int idx = F.bid * (NWAVES * 64) + F.tid; idx < T * 8; idx += F.G * NWAVES * 64) { const int row = idx >> 3, i = idx & 7;
          const float invf = exp2f(-(float)i * 0.125f * 18.931568569324174f); const float ang = (float)positions[row] * invf;
          rope[row * 16 + i] = cosf(ang); rope[row * 16 + 8 + i] = sinf(ang); } }
    { const GAS float* sw = ka_in(7); GAS unsigned* dst = (GAS unsigned*)(ws + WS_SGUW);
      for (int idx = F.bid * (NWAVES * 64) + F.tid; idx < DEPTH * 8 * BLK * BLK / 2; idx += F.G * NWAVES * 64) { const int s2 = (idx & 63) * 2, t = (idx >> 6) & 127;
          const float a = sw[(size_t)idx * 2], b = sw[(size_t)idx * 2 + 1]; dst[idx] = pk2(s2 <= t ? a : 0.f, s2 + 1 <= t ? b : 0.f); } }
    const GAS float* x = ka_in(0); gbf16* XN = WSP(ws, WS_XN);
    f32x4 gn[4]; load_row_f32(ka_in(2), F.lane, gn);
#pragma unroll 1
    for (int m0 = gw; m0 < T; m0 += NR * NGW) {
        f32x4 v[NR][4]; int mm[NR]; bool ok[NR]; float ss[NR];
#pragma unroll
        for (int q = 0; q < NR; ++q) { ok[q] = (m0 + q * NGW < T); mm[q] = ok[q] ? m0 + q * NGW : m0; load_row_f32_nt(x + (size_t)mm[q] * D, F.lane, v[q]); }
#pragma unroll
        for (int q = 0; q < NR; ++q) ss[q] = row_ssq_local(v[q]);
        wave_sum_n<NR>(ss);
#pragma unroll
        for (int q = 0; q < NR; ++q) { const float r = 1.0f / sqrtf(ss[q] * (1.0f / D) + EPS);
#pragma unroll
            for (int j = 0; j < 4; ++j) v[q][j] = v[q][j] * r * gn[j]; }
        store_rows_i8<NR>((GAS unsigned char*)XN, (GAS float*)(ws + WS_SA), v, mm, ok, F.lane);
    }
}

__device__ __forceinline__ void ph_gemm_in(const Frame& F_, int layer) {
    const Frame F = opaque(F_);
    GAS unsigned char* ws = ka_ptr(KA_WS);
    pg8::Gemm g{(const pg8::gbf*)WSP(ws, WS_XN), (const pg8::gbf*)(ws + WS_WIN + (size_t)layer * INW * D), D / 2, 0u, 0u, 0}; pg8::DenseSched S; S.init(T / 256, INW / 256, F.G, F.bid);
    pg8::EpiStoreq E{(pg8::gbf*)WSP(ws, WS_Z), INW, 0, (const GAS float*)(ws + WS_SA), (const GAS float*)(ws + WS_SWIN) + layer * INW};
    pg8::gemm_phase<pg8::EpiStoreq, pg8::DenseSched, false, 2>(F.lds, g, S, E);
    const int nidle = win_idle_blocks(F.G), first_idle = F.G - nidle;
    if (nidle > 0 && F.bid >= first_idle) {
        __syncthreads();
        LAS float* scr = (LAS float*)(F.lds + F.wave * 16384);
        const int ndefer = moe_deferred(F.G), per_layer = nidle * NWAVES * MOE_DEFER_PER_WAVE;
        const int w = (F.bid - first_idle) * NWAVES + F.wave;
#pragma unroll 1
        for (int j = 0; j < MOE_DEFER_PER_WAVE; ++j) { const int r = layer * per_layer + j * (nidle * NWAVES) + w; if (r < ndefer) moe_convert_item(ws, r, scr, F.lane); }
    }
}
__device__ __forceinline__ void ph_gemm_out(const Frame& F_, int layer) {
    const Frame F = opaque(F_);
    GAS unsigned char* ws = ka_ptr(KA_WS);
    pg8::DenseSched S; S.init(T / 256, D / 256, F.G, F.bid);
    pg8::EpiStore E{(pg8::gbf*)(ka_ptr(KA_OUT) + OUT_MIX), D, 0, 0};
    if (layer == 0) { pg8::Gemm g{(const pg8::gbf*)WSP(ws, WS_MERGED), (const pg8::gbf*)WSP(ws, WS_WOUT), D, 0u, 0u, 0}; pg8::gemm_phase<pg8::EpiStore, pg8::DenseSched, false>(F.lds, g, S, E); }
    else { pg8::Gemm g{(const pg8::gbf*)WSP(ws, WS_MERGED), (const pg8::gbf*)(ws + WS_WOUT + (size_t)2 * D * D), D / 2, 0x7d7d7d7du  , 0x79797979u  , 0}; pg8::gemm_phase<pg8::EpiStore, pg8::DenseSched, false, 1>(F.lds, g, S, E); }
}
__device__ __forceinline__ void ph_gemm_gu(const Frame& F_) {
    const Frame F = opaque(F_);
    GAS unsigned char* ws = ka_ptr(KA_WS);
    pg8::Gemm g{(const pg8::gbf*)WSP(ws, WS_XN), (const pg8::gbf*)WSP(ws, WS_WGU), D / 2, 0u, 0u, 0}; pg8::DenseSched S; S.init(T / 256, 2 * FFD / 256, F.G, F.bid);
    pg8::EpiSwiGLUq8 E{ws + WS_HID, FFD, 0, (const GAS float*)(ws + WS_SA), (const GAS float*)(ws + WS_SW), HID_SCALE};
    pg8::gemm_phase<pg8::EpiSwiGLUq8, pg8::DenseSched, false, 2>(F.lds, g, S, E);
}
__device__ __forceinline__ void ph_gemm_down(const Frame& F_) {
    const Frame F = opaque(F_);
    GAS unsigned char* ws = ka_ptr(KA_WS);
    pg8::Gemm g{(const pg8::gbf*)WSP(ws, WS_HID), (const pg8::gbf*)WSP(ws, WS_WD), FFD / 2, 0x7d7d7d7du  , 0x78787878u  , 0}; pg8::DenseSched S; S.init(T / 256, D / 256, F.G, F.bid);
    pg8::EpiStore E{(pg8::gbf*)(ka_ptr(KA_OUT) + OUT_MIX), D, 0, 0};
    pg8::gemm_phase<pg8::EpiStore, pg8::DenseSched, false, 1>(F.lds, g, S, E);
}
__device__ __forceinline__ void ph_moe_gu(const Frame& F_) {
    const Frame F = opaque(F_);
    GAS unsigned char* ws = ka_ptr(KA_WS);
    moe_table(F, ws);
    const LAS int* MOETBL = (const LAS int*)(F.lds + MOETBL_OFF);
    const int ntile = MOETBL[8];
    pg8::Gemm g{(const pg8::gbf*)WSP(ws, WS_XN), (const pg8::gbf*)WSP(ws, WS_MWGU), D / 2, 0x7e7e7e7eu  , 0x7a7a7a7au  , 0, 0x7b7b7b7bu  }; pg8::MoeSched S; S.init(ntile, 2 * FFE / 256, F.G, F.bid);
    S.pm0 = 0; S.tbl = MOETBL; S.inv = (const GAS int*)(ws + WS_INV); S.estride = (size_t)2 * FFE * D; S.a1 = nullptr; S.split = 0;
    LAS unsigned short* rowtab = (LAS unsigned short*)(F.lds + ROWTAB_OFF); S.rowtab = rowtab;
    { const int hf = F.tid >> 8, r = F.tid & 255; pg8::Unit u0;
      if (S.next(0, u0)) {
#pragma unroll 1
        for (int i0 = 0; i0 < ROWTAB_UNITS; i0 += 8) { int v[4]; bool ok[4];
#pragma unroll
          for (int k = 0; k < 4; ++k) { pg8::Unit u; const int i = i0 + 2 * k + hf; ok[k] = S.next(i, u); if (!ok[k]) u = u0;
              const int e = S.expert(u.pm), cnt = MOETBL[16 + e], local = (u.pm - MOETBL[e]) * 256 + r; const int t_ = S.inv[e * T + (local < cnt ? local : 0)]; v[k] = local < cnt ? t_ : 0; }
#pragma unroll
          for (int k = 0; k < 4; ++k) { const int i = i0 + 2 * k + hf; if (ok[k]) rowtab[i * 256 + r] = (unsigned short)v[k]; } } } }
    __syncthreads();
    static_assert(MOE_HID_SCALE == 4.f, "MOE_WU_SCALE carries the hidden scale");
    pg8::EpiSwiGLU8p E{ka_ptr(KA_OUT), ws + WS_HIDC, MOE_CHUNK, FFE};
    pg8::gemm_phase<pg8::EpiSwiGLU8p, pg8::MoeSched, true, 3>(F.lds, g, S, E);
}
__device__ __forceinline__ void ph_moe_down(const Frame& F_) {
    const Frame F = opaque(F_);
    GAS unsigned char* ws = ka_ptr(KA_WS);
    moe_table(F, ws);
    const LAS int* MOETBL = (const LAS int*)(F.lds + MOETBL_OFF);
    const int ntile = MOETBL[8];
    {
        pg8::Gemm g{(const pg8::gbf*)ka_ptr(KA_OUT), (const pg8::gbf*)WSP(ws, WS_MWD), FFE / 2, E8M0_HID, E8M0_WD, 0}; pg8::MoeSched S; S.init(2 * MOE_CHUNK, D / 256, F.G, F.bid);
        S.pm0 = 0; S.tbl = MOETBL; S.inv = (const GAS int*)(ws + WS_INV); S.estride = (size_t)D * FFE; S.rowtab = nullptr; S.a1 = (pg8::gcp)(ws + WS_HIDC); S.split = MOE_CHUNK;
        pg8::EpiStore8 E{ws + WS_FS, D, 0, MOE_FS_SCALE};
        pg8::gemm_phase<pg8::EpiStore8, pg8::MoeSched, false, 1>(F.lds, g, S, E);
    }
    const int ntail = ntile - 2 * MOE_CHUNK;
    if (ntail > 0) {
        pg8::Gemm g{(const pg8::gbf*)WSP(ws, WS_HIDC), (const pg8::gbf*)WSP(ws, WS_MWD), FFE / 2, E8M0_HID, E8M0_WD, 4}; pg8::MoeTailSched S;
        S.nunits = ntail * 4 * MOE_SPLITK; S.G = F.G; S.c = F.bid; S.pm0a = MOE_CHUNK; S.tbl = MOETBL; S.estride = (size_t)D * FFE; S.nks = MOE_SPLITK;
        pg8::EpiStore E{(pg8::gbf*)WSP(ws, WS_FSP), D, 2 * MOE_CHUNK, (size_t)MOE_TAIL_TILES * 256 * D};
        pg8::gemm_phase<pg8::EpiStore, pg8::MoeTailSched, false, 1>(F.lds, g, S, E);
    }
}

typedef float f32x16 __attribute__((ext_vector_type(16)));
typedef short s16x8 __attribute__((ext_vector_type(8)));
typedef short s16x4 __attribute__((ext_vector_type(4)));
typedef float f32x2_t __attribute__((ext_vector_type(2))); typedef __bf16 bf16x2_t __attribute__((ext_vector_type(2)));
__device__ __forceinline__ unsigned cvtpk(float lo, float hi) { f32x2_t v = {lo, hi}; bf16x2_t b = __builtin_convertvector(v, bf16x2_t); return __builtin_bit_cast(unsigned, b); }
__device__ __forceinline__ int crow(int r, int hi) { return (r & 3) + 8 * (r >> 2) + 4 * hi; }
__device__ __forceinline__ int kimg_off(int row, int chunk) { return row * 128 + ((chunk ^ ((row >> 1) & 7)) << 4); }
__device__ __forceinline__ int vimg_off(int row, int chunk) { return row * 128 + ((((chunk >> 2) ^ ((row >> 1) & 1)) << 6) | ((chunk & 3) << 4)); }
__device__ __forceinline__ s16x4 tr16(const LAS unsigned char* p) { return __builtin_bit_cast(s16x4, __builtin_amdgcn_ds_read_tr16_b64_v4i16((LAS s16x4*)p)); }
#define MFMA32(a, b, c) __builtin_amdgcn_mfma_f32_32x32x16_bf16((a), (b), (c), 0, 0, 0)

__device__ __forceinline__ void ph_mixer(const Frame& F_, int layer) {
    const Frame F = opaque(F_);
    GAS unsigned char* ws = ka_ptr(KA_WS);
    const gbf16* Z = WSP(ws, WS_Z); gbf16* MERGED = WSP(ws, WS_MERGED);
    const GAS float* rope = (const GAS float*)(ka_ptr(KA_OUT) + OUT_ROPE);
    LAS unsigned char* Kimg = F.lds; LAS unsigned char* Vimg = F.lds + 65536; LAS float* ssq = (LAS float*)(F.lds + P2_SSQ);
#define STAGE_LANES int tid_s = F.tid; asm volatile("" : "+v"(tid_s)); const int lane = tid_s & 63, qr = lane & 31, hi = lane >> 5, i16 = lane & 15, tq = i16 >> 2, tp = i16 & 3, g16 = (lane >> 4) & 1; (void)qr; (void)hi; (void)tq; (void)tp; (void)g16
    for (int unit = F.bid; unit < BATCH * (SEQ / BLK); unit += F.G) {
        const int b = unit / (SEQ / BLK), nb = unit % (SEQ / BLK);
        const int row0 = b * SEQ + nb * BLK;
        __syncthreads();
        v4u qwn[4]; f32x4 rpn[4];
        { int t0_ = F.tid; asm volatile("" : "+v"(t0_)); const int ln_ = t0_ & 63, qr_ = ln_ & 31, hi_ = ln_ >> 5; const int row = row0 + qr_;
          const GAS v4u* qp = (const GAS v4u*)(Z + (size_t)row * INW + ZQ + F.wave * HD + 8 * hi_); const GAS f32x4* rp = (const GAS f32x4*)(rope + (size_t)row * 16);
#pragma unroll
          for (int d0 = 0; d0 < 4; ++d0) { qwn[d0] = qp[2 * d0]; rpn[d0] = rp[d0]; } }
        {
            int tid_s = F.tid; asm volatile("" : "+v"(tid_s));
            const int j = tid_s >> 1, kvh = tid_s & 1; const int row = row0 - BLK + j;
            const bool ok = (nb > 0 || j >= BLK);
            LAS unsigned char* kd = Kimg + kvh * 32768; LAS unsigned char* vd = Vimg + kvh * 32768;
            {
                v4u vv[8], kk[8]; f32x4 c0 = (f32x4){1.f, 1.f, 1.f, 1.f}, c1 = c0, s0 = (f32x4){0.f, 0.f, 0.f, 0.f}, s1 = s0;
#pragma unroll
                for (int c = 0; c < 8; ++c) { vv[c] = (v4u){0u, 0u, 0u, 0u}; kk[c] = (v4u){0u, 0u, 0u, 0u}; }
                if (ok) { const GAS v4u* vp = (const GAS v4u*)(Z + (size_t)row * INW + ZV + kvh * HD); const GAS v4u* kp = (const GAS v4u*)(Z + (size_t)row * INW + ZK + kvh * HD);
                    const GAS f32x4* rp = (const GAS f32x4*)(rope + (size_t)row * 16);
#pragma unroll
                    for (int c = 0; c < 8; ++c) { vv[c] = vp[c]; kk[c] = kp[c]; }
                    c0 = rp[0]; c1 = rp[1]; s0 = rp[2]; s1 = rp[3]; }
#pragma unroll
                for (int c = 0; c < 8; ++c) *(LAS v4u*)(vd + vimg_off(j, c)) = vv[c];
                {
                    float cs[8] = {c0[0], c0[1], c0[2], c0[3], c1[0], c1[1], c1[2], c1[3]}, sn[8] = {s0[0], s0[1], s0[2], s0[3], s1[0], s1[1], s1[2], s1[3]};
                    float r1[8], r2[8];
#pragma unroll
                    for (int i = 0; i < 4; ++i) { const float a0 = bflo(kk[0][i]), a1 = bfhi(kk[0][i]), b0 = bflo(kk[1][i]), b1 = bfhi(kk[1][i]);
                        r1[2 * i] = a0 * cs[2 * i] - b0 * sn[2 * i]; r2[2 * i] = b0 * cs[2 * i] + a0 * sn[2 * i];
                        r1[2 * i + 1] = a1 * cs[2 * i + 1] - b1 * sn[2 * i + 1]; r2[2 * i + 1] = b1 * cs[2 * i + 1] + a1 * sn[2 * i + 1]; }
#pragma unroll
                    for (int i = 0; i < 4; ++i) { kk[0][i] = pk2(r1[2 * i], r1[2 * i + 1]); kk[1][i] = pk2(r2[2 * i], r2[2 * i + 1]); }
                }
#pragma unroll
                for (int c = 0; c < 8; ++c) *(LAS v4u*)(kd + kimg_off(j, c)) = kk[c];
            }
        }
        __syncthreads();
        {
            STAGE_LANES;
            const int h = F.wave, kvh = h >> 2;
            const float sink2 = ka_in(4)[layer * NQH + h] * 1.4426950408889634f; const float sc = 0.125f * 1.4426950408889634f;
            const GAS float* g_a = ka_in(9) + layer * ATTW;
            const LAS unsigned char* Kb = Kimg + kvh * 32768; const LAS unsigned char* Vb = Vimg + kvh * 32768;
            int koff[4];
#pragma unroll
            for (int d0 = 0; d0 < 4; ++d0) koff[d0] = kimg_off(qr, 2 * d0 + hi);
            int voff[2];
#pragma unroll
            for (int d0 = 0; d0 < 2; ++d0) voff[d0] = (4 * hi + tq) * 128 + ((d0 ^ (tq >> 1)) << 6) + 32 * g16 + 8 * tp;
#pragma unroll 1
            for (int qi = 0; qi < 4; ++qi) {
                const int row = row0 + 32 * qi + qr;
                s16x8 qf[4];
                { v4u qw[4]; f32x4 rpc[4];
#pragma unroll
                  for (int d0 = 0; d0 < 4; ++d0) { qw[d0] = qwn[d0]; rpc[d0] = rpn[d0]; }
                  if (qi < 3) { const int rown = row + 32; const GAS v4u* qp = (const GAS v4u*)(Z + (size_t)rown * INW + ZQ + h * HD + 8 * hi); const GAS f32x4* rp = (const GAS f32x4*)(rope + (size_t)rown * 16);
#pragma unroll
                      for (int d0 = 0; d0 < 4; ++d0) { qwn[d0] = qp[2 * d0]; rpn[d0] = rp[d0]; } }
                  { v4u pw;
#pragma unroll
                    for (int e = 0; e < 4; ++e) pw[e] = xchg32(qw[0][e], hi);
                    const f32x4 c0 = rpc[0], c1 = rpc[1], s0 = rpc[2], s1 = rpc[3];
                    const float cs[8] = {c0[0], c0[1], c0[2], c0[3], c1[0], c1[1], c1[2], c1[3]}, sn[8] = {s0[0], s0[1], s0[2], s0[3], s1[0], s1[1], s1[2], s1[3]};
                    const float sg = hi ? 1.0f : -1.0f; float o8[8];
#pragma unroll
                    for (int e = 0; e < 4; ++e) { o8[2 * e] = bflo(qw[0][e]) * cs[2 * e] + sg * bflo(pw[e]) * sn[2 * e]; o8[2 * e + 1] = bfhi(qw[0][e]) * cs[2 * e + 1] + sg * bfhi(pw[e]) * sn[2 * e + 1]; }
#pragma unroll
                    for (int e = 0; e < 4; ++e) qw[0][e] = cvtpk(o8[2 * e], o8[2 * e + 1]); }
#pragma unroll
                  for (int d0 = 0; d0 < 4; ++d0) qf[d0] = __builtin_bit_cast(s16x8, qw[d0]); }
                f32x16 st[5];
#pragma unroll
                for (int a = 0; a < 5; ++a) {
                    const int kt = qi + a;
                    f32x16 acc;
#pragma unroll
                    for (int r = 0; r < 16; ++r) acc[r] = 0.f;
                    if (nb > 0 || kt >= 4) {
#pragma unroll
                        for (int d0 = 0; d0 < 4; ++d0) { const s16x8 kf = *(const LAS s16x8*)(Kb + kt * 4096 + koff[d0]); acc = MFMA32(kf, qf[d0], acc); }
                    }
                    st[a] = acc;
                }
                float mx = -INFINITY;
#pragma unroll
                for (int a = 0; a < 5; ++a) { const bool tile_ok = (nb > 0) || (qi + a >= 4);
#pragma unroll
                    for (int r = 0; r < 16; ++r) { const int kr = crow(r, hi); bool valid = tile_ok; if (a == 0) valid = valid && (kr > qr); if (a == 4) valid = valid && (kr <= qr);
                        const float v = valid ? st[a][r] : -INFINITY; st[a][r] = v; mx = fmaxf(mx, v); } }
                mx = swap32_max(mx);
                const float M = fmaxf(mx * sc, sink2);
                float lsum = 0.f;
#pragma unroll
                for (int a = 0; a < 5; ++a)
#pragma unroll
                    for (int r = 0; r < 16; ++r) { const float p = __builtin_amdgcn_exp2f(st[a][r] * sc - M); st[a][r] = p; lsum += p; }
                lsum = swap32_add(lsum);
                lsum += __builtin_amdgcn_exp2f(sink2 - M);
                f32x16 o0, o1;
#pragma unroll
                for (int r = 0; r < 16; ++r) { o0[r] = 0.f; o1[r] = 0.f; }
#pragma unroll
                for (int a = 0; a < 5; ++a) {
                    const int kt = qi + a;
                    if (nb > 0 || kt >= 4) {
#pragma unroll
                        for (int s2 = 0; s2 < 2; ++s2) {
                            v4u pw; pw.x = cvtpk(st[a][8 * s2], st[a][8 * s2 + 1]); pw.y = cvtpk(st[a][8 * s2 + 2], st[a][8 * s2 + 3]); pw.z = cvtpk(st[a][8 * s2 + 4], st[a][8 * s2 + 5]); pw.w = cvtpk(st[a][8 * s2 + 6], st[a][8 * s2 + 7]);
                            const s16x8 pf = __builtin_bit_cast(s16x8, pw);
                            const LAS unsigned char* vb = Vb + (32 * kt + 16 * s2) * 128;
                            { const s16x4 lo = tr16(vb + voff[0]), h4 = tr16(vb + 8 * 128 + voff[0]); const s16x8 vf = __builtin_shufflevector(lo, h4, 0, 1, 2, 3, 4, 5, 6, 7); o0 = MFMA32(vf, pf, o0); }
                            { const s16x4 lo = tr16(vb + voff[1]), h4 = tr16(vb + 8 * 128 + voff[1]); const s16x8 vf = __builtin_shufflevector(lo, h4, 0, 1, 2, 3, 4, 5, 6, 7); o1 = MFMA32(vf, pf, o1); }
                        }
                    }
                }
                const float il = 1.0f / lsum; float sq = 0.f;
#pragma unroll
                for (int r = 0; r < 16; ++r) { o0[r] *= il; o1[r] *= il; sq += o0[r] * o0[r] + o1[r] * o1[r]; }
                sq = swap32_add(sq);
                if (hi == 0) ssq[(32 * qi + qr) * 8 + h] = sq;
                const GAS float* gap = g_a + h * HD + 4 * hi;
                f32x4 ga[4], gb[4];
#pragma unroll
                for (int g4 = 0; g4 < 4; ++g4) { ga[g4] = *(const GAS f32x4*)(gap + 8 * g4); gb[g4] = *(const GAS f32x4*)(gap + 32 + 8 * g4); }
                __syncthreads();
                float rs;
                { const LAS float* sp = ssq + (32 * qi + qr) * 8; const f32x4 p0 = *(const LAS f32x4*)sp, p1 = *(const LAS f32x4*)(sp + 4);
                  const float tot = ((p0[0] + p0[1]) + (p0[2] + p0[3])) + ((p1[0] + p1[1]) + (p1[2] + p1[3])); rs = 1.0f / sqrtf(tot * (1.0f / 512.0f) + EPS); }
                if (layer == 0) {
                GAS unsigned char* orow = (GAS unsigned char*)(MERGED + (size_t)row * D + h * HD);
                v2u pa[4], pb[4];
#pragma unroll
                for (int g4 = 0; g4 < 4; ++g4) {
                    pa[g4] = (v2u){cvtpk(o0[4 * g4] * rs * ga[g4][0], o0[4 * g4 + 1] * rs * ga[g4][1]), cvtpk(o0[4 * g4 + 2] * rs * ga[g4][2], o0[4 * g4 + 3] * rs * ga[g4][3])};
                    pb[g4] = (v2u){cvtpk(o1[4 * g4] * rs * gb[g4][0], o1[4 * g4 + 1] * rs * gb[g4][1]), cvtpk(o1[4 * g4 + 2] * rs * gb[g4][2], o1[4 * g4 + 3] * rs * gb[g4][3])};
                }
#pragma unroll
                for (int k = 0; k < 4; k += 2) { store_pair16(orow + 16 * k, hi, pa[k], pa[k + 1]); store_pair16(orow + 64 + 16 * k, hi, pb[k], pb[k + 1]); }
                } else {
                GAS unsigned char* orow = (GAS unsigned char*)MERGED + (size_t)row * D + h * HD;
                unsigned pa[4], pb[4]; const float rq = rs * MERGED_SCALE;
#pragma unroll
                for (int g4 = 0; g4 < 4; ++g4) {
                    pa[g4] = pk4_fp8(o0[4 * g4] * rq * ga[g4][0], o0[4 * g4 + 1] * rq * ga[g4][1], o0[4 * g4 + 2] * rq * ga[g4][2], o0[4 * g4 + 3] * rq * ga[g4][3]);
                    pb[g4] = pk4_fp8(o1[4 * g4] * rq * gb[g4][0], o1[4 * g4 + 1] * rq * gb[g4][1], o1[4 * g4 + 2] * rq * gb[g4][2], o1[4 * g4 + 3] * rq * gb[g4][3]);
                }
                store_quad8(orow, hi, pa); store_quad8(orow + 32, hi, pb); }
            }
        }
        __syncthreads();
        {
            STAGE_LANES;
            const int g = F.wave, hf = lane & 1; LAS unsigned char* vnl = F.lds + g * 16384;
            const GAS float* lg = ka_in(5) + layer * SGUW + g * HD + hf * 32; const GAS float* lb = ka_in(6) + layer * SGUW + g * HD + hf * 32;
            v4u zraw[4][4];
#pragma unroll
            for (int p = 0; p < 4; ++p) { const GAS v4u* zp = (const GAS v4u*)(Z + (size_t)(row0 + 32 * p + (lane >> 1)) * INW + ZVV + g * HD + hf * 32);
#pragma unroll
                for (int c = 0; c < 4; ++c) zraw[p][c] = zp[c]; }
#pragma unroll
            for (int p = 0; p < 4; ++p) {
                const int sidx = 32 * p + (lane >> 1);
                float v[32];
#pragma unroll
                for (int c = 0; c < 4; ++c) { const v4u w = zraw[p][c];
#pragma unroll
                    for (int e = 0; e < 4; ++e) { v[8 * c + 2 * e] = gelu_tanh(bflo(w[e])); v[8 * c + 2 * e + 1] = gelu_tanh(bfhi(w[e])); } }
                float mu = 0.f;
#pragma unroll
                for (int d = 0; d < 32; ++d) mu += v[d];
                mu = xor1_add(mu);
                mu *= (1.0f / 64.0f); float var = 0.f;
#pragma unroll
                for (int d = 0; d < 32; ++d) { v[d] -= mu; var += v[d] * v[d]; }
                var = xor1_add(var);
                const float rs = 1.0f / sqrtf(var * (1.0f / 64.0f) + EPS);
#pragma unroll
                for (int c = 0; c < 4; ++c) { float t[8];
#pragma unroll
                    for (int e = 0; e < 8; ++e) t[e] = v[8 * c + e] * rs * lg[8 * c + e] + lb[8 * c + e];
                    v4u w; w.x = cvtpk(t[0], t[1]); w.y = cvtpk(t[2], t[3]); w.z = cvtpk(t[4], t[5]); w.w = cvtpk(t[6], t[7]);
                    *(LAS v4u*)(vnl + vimg_off(sidx, 4 * hf + c)) = w; }
            }
            __syncthreads();
            const GAS unsigned char* Wb = (const GAS unsigned char*)(ws + WS_SGUW) + (size_t)(layer * 8 + g) * (BLK * BLK * 2);
            const GAS float* sgu_b = ka_in(8) + (layer * 8 + g) * BLK; const GAS float* g_s = ka_in(10) + layer * SGUW;
            int vo[2];
#pragma unroll
            for (int d0 = 0; d0 < 2; ++d0) vo[d0] = (8 * hi + tq) * 128 + ((d0 ^ (tq >> 1)) << 6) + 32 * g16 + 8 * tp;
            s16x8 wfn[8]; v2u uvan[4], uvbn[4]; float bsn;
#define SGU_LOADS(tbx) do { const int t_ = 32 * (tbx) + qr; \
                _Pragma("unroll") for (int ks = 0; ks < 2 * (tbx) + 2; ++ks) wfn[ks] = *(const GAS s16x8*)(Wb + (size_t)t_ * 256 + 32 * ks + 16 * hi); \
                bsn = sgu_b[t_]; const GAS unsigned char* urow_ = (const GAS unsigned char*)(Z + (size_t)(row0 + t_) * INW + ZU + g * HD) + (hi ? 16 : 0); \
                _Pragma("unroll") for (int k = 0; k < 4; k += 2) { const v4u la = *(const GAS v4u*)(urow_ + 16 * k), lb = *(const GAS v4u*)(urow_ + 64 + 16 * k); \
                    uvan[k] = (v2u){la.x, la.y}; uvan[k + 1] = (v2u){la.z, la.w}; uvbn[k] = (v2u){lb.x, lb.y}; uvbn[k + 1] = (v2u){lb.z, lb.w}; } } while (0)
            SGU_LOADS(0);
#pragma unroll
            for (int tb = 0; tb < 4; ++tb) {
                const int t = 32 * tb + qr; const int row = row0 + t;
                f32x16 c0, c1;
#pragma unroll
                for (int r = 0; r < 16; ++r) { c0[r] = 0.f; c1[r] = 0.f; }
                s16x8 wf[8]; v2u uva[4], uvb[4];
#pragma unroll
                for (int ks = 0; ks < 2 * tb + 2; ++ks) wf[ks] = wfn[ks];
#pragma unroll
                for (int g4 = 0; g4 < 4; ++g4) { uva[g4] = uvan[g4]; uvb[g4] = uvbn[g4]; }
#pragma unroll
                for (int k = 0; k < 4; k += 2) { pl32_swap2(uva[k], uva[k + 1]); pl32_swap2(uvb[k], uvb[k + 1]); }
                const float bs = bsn;
                if (tb < 3) SGU_LOADS(tb + 1);
#pragma unroll
                for (int ks = 0; ks < 2 * tb + 2; ++ks) {
                    const LAS unsigned char* vb = vnl + 16 * ks * 128;
                    { const s16x4 lo = tr16(vb + vo[0]), h4 = tr16(vb + 4 * 128 + vo[0]); const s16x8 vf = __builtin_shufflevector(lo, h4, 0, 1, 2, 3, 4, 5, 6, 7); c0 = MFMA32(vf, wf[ks], c0); }
                    { const s16x4 lo = tr16(vb + vo[1]), h4 = tr16(vb + 4 * 128 + vo[1]); const s16x8 vf = __builtin_shufflevector(lo, h4, 0, 1, 2, 3, 4, 5, 6, 7); c1 = MFMA32(vf, wf[ks], c1); }
                }
                float sq = 0.f;
#pragma unroll
                for (int g4 = 0; g4 < 4; ++g4) {
                    const v2u ua = uva[g4], ub = uvb[g4];
                    c0[4 * g4] = gelu_tanh(bflo(ua.x)) * (c0[4 * g4] + bs); c0[4 * g4 + 1] = gelu_tanh(bfhi(ua.x)) * (c0[4 * g4 + 1] + bs); c0[4 * g4 + 2] = gelu_tanh(bflo(ua.y)) * (c0[4 * g4 + 2] + bs); c0[4 * g4 + 3] = gelu_tanh(bfhi(ua.y)) * (c0[4 * g4 + 3] + bs);
                    c1[4 * g4] = gelu_tanh(bflo(ub.x)) * (c1[4 * g4] + bs); c1[4 * g4 + 1] = gelu_tanh(bfhi(ub.x)) * (c1[4 * g4 + 1] + bs); c1[4 * g4 + 2] = gelu_tanh(bflo(ub.y)) * (c1[4 * g4 + 2] + bs); c1[4 * g4 + 3] = gelu_tanh(bfhi(ub.y)) * (c1[4 * g4 + 3] + bs);
                }
#pragma unroll
                for (int r = 0; r < 16; ++r) sq += c0[r] * c0[r] + c1[r] * c1[r];
                sq = swap32_add(sq);
                if (hi == 0) ssq[1024 + t * 8 + g] = sq;
                const GAS float* gsp = g_s + g * HD + 4 * hi;
                f32x4 ga[4], gb[4];
#pragma unroll
                for (int g4 = 0; g4 < 4; ++g4) { ga[g4] = *(const GAS f32x4*)(gsp + 8 * g4); gb[g4] = *(const GAS f32x4*)(gsp + 32 + 8 * g4); }
                __syncthreads();
                float rs;
                { const LAS float* sp = ssq + 1024 + t * 8; const f32x4 p0 = *(const LAS f32x4*)sp, p1 = *(const LAS f32x4*)(sp + 4);
                  const float tot = ((p0[0] + p0[1]) + (p0[2] + p0[3])) + ((p1[0] + p1[1]) + (p1[2] + p1[3])); rs = 1.0f / sqrtf(tot * (1.0f / 512.0f) + EPS); }
                if (layer == 0) {
                GAS unsigned char* orow = (GAS unsigned char*)(MERGED + (size_t)row * D + ATTW + g * HD);
                v2u pa[4], pb[4];
#pragma unroll
                for (int g4 = 0; g4 < 4; ++g4) {
                    pa[g4] = (v2u){cvtpk(c0[4 * g4] * rs * ga[g4][0], c0[4 * g4 + 1] * rs * ga[g4][1]), cvtpk(c0[4 * g4 + 2] * rs * ga[g4][2], c0[4 * g4 + 3] * rs * ga[g4][3])};
                    pb[g4] = (v2u){cvtpk(c1[4 * g4] * rs * gb[g4][0], c1[4 * g4 + 1] * rs * gb[g4][1]), cvtpk(c1[4 * g4 + 2] * rs * gb[g4][2], c1[4 * g4 + 3] * rs * gb[g4][3])};
                }
#pragma unroll
                for (int k = 0; k < 4; k += 2) { store_pair16(orow + 16 * k, hi, pa[k], pa[k + 1]); store_pair16(orow + 64 + 16 * k, hi, pb[k], pb[k + 1]); }
                } else {
                GAS unsigned char* orow = (GAS unsigned char*)MERGED + (size_t)row * D + ATTW + g * HD;
                unsigned pa[4], pb[4]; const float rq = rs * MERGED_SCALE;
#pragma unroll
                for (int g4 = 0; g4 < 4; ++g4) {
                    pa[g4] = pk4_fp8(c0[4 * g4] * rq * ga[g4][0], c0[4 * g4 + 1] * rq * ga[g4][1], c0[4 * g4 + 2] * rq * ga[g4][2], c0[4 * g4 + 3] * rq * ga[g4][3]);
                    pb[g4] = pk4_fp8(c1[4 * g4] * rq * gb[g4][0], c1[4 * g4 + 1] * rq * gb[g4][1], c1[4 * g4 + 2] * rq * gb[g4][2], c1[4 * g4 + 3] * rq * gb[g4][3]);
                }
                store_quad8(orow, hi, pa); store_quad8(orow + 32, hi, pb); }
            }
        }
    }
    __syncthreads();
#undef SGU_LOADS
#undef STAGE_LANES
}

template <int layer> __device__ __forceinline__ void ph_norm_mix(const Frame& F_) {
    const Frame F = opaque(F_);
    GAS unsigned char* ws = ka_ptr(KA_WS);
    const gbf16* MIX = (const gbf16*)(ka_ptr(KA_OUT) + OUT_MIX); gbf16* XN = WSP(ws, WS_XN);
    GAS _Float16* H16 = (GAS _Float16*)(ws + WS_H16);
    const GAS float* x = ka_in(0);
    f32x4 gpost[4], gffn[4]; load_row_f32(ka_in(12) + layer * D, F.lane, gpost); load_row_f32(ka_in(13) + layer * D, F.lane, gffn);
    const int rpb = (T + F.G - 1) / F.G;
    const int rb0 = F.bid * rpb, rb1 = (rb0 + rpb < T) ? rb0 + rpb : T;
    LAS unsigned* sel = (LAS unsigned*)(F.lds + ROUTE_OFF);
    const GAS float* moe_router = ka_in(18);
    LAS float* xscr = (LAS float*)(F.lds + F.wave * 9216);
    constexpr int RT_OFF = NWAVES * 9216;
    static_assert(NR == 4 && RT_OFF + 32768 <= ROWTAB_OFF, "norm_mix LDS layout");
    const LAS f32x4* rt = (const LAS f32x4*)(F.lds + RT_OFF);
    if (layer == 1) {
        for (int idx = F.tid; idx < 2048; idx += NWAVES * 64) { const int jc = idx >> 7, half = (idx >> 6) & 1, ln = idx & 63, k = 4 * ln + 256 * (jc >> 2) + (jc & 3);
            ((LAS f32x4*)(F.lds + RT_OFF))[idx] = *(const GAS f32x4*)(moe_router + (size_t)k * 8 + 4 * half); }
        __syncthreads();
    }
    GAS v4u* TOKINFO = (GAS v4u*)(ws + WS_TOKINFO);
#pragma unroll 1
    for (int m0 = rb0 + F.wave; m0 < rb1; m0 += NR * NWAVES) {
        f32x4 v[NR][4], hh[NR][4]; int mm[NR]; bool ok[NR];
#pragma unroll
        for (int q = 0; q < NR; ++q) { ok[q] = (m0 + q * NWAVES < rb1); mm[q] = ok[q] ? m0 + q * NWAVES : m0;
            load_row_bf16(MIX + (size_t)mm[q] * D, F.lane, v[q]);
            if (layer == 0) load_row_f32_nt(x + (size_t)mm[q] * D, F.lane, hh[q]); else load_row_f16(H16 + (size_t)mm[q] * D, F.lane, hh[q]); }
        float ss[NR];
#pragma unroll
        for (int q = 0; q < NR; ++q) ss[q] = row_ssq_local(v[q]);
        wave_sum_n<NR>(ss);
#pragma unroll
        for (int q = 0; q < NR; ++q) { const float r = 1.0f / sqrtf(ss[q] * (1.0f / D) + EPS);
#pragma unroll
            for (int j = 0; j < 4; ++j) hh[q][j] = hh[q][j] + v[q][j] * r * gpost[j];
            if (ok[q]) store_row_f16(H16 + (size_t)mm[q] * D, F.lane, hh[q]);
            ss[q] = row_ssq_local(hh[q]); }
        wave_sum_n<NR>(ss);
#pragma unroll
        for (int q = 0; q < NR; ++q) { const float r2 = 1.0f / sqrtf(ss[q] * (1.0f / D) + EPS);
#pragma unroll
            for (int j = 0; j < 4; ++j) hh[q][j] = hh[q][j] * r2 * gffn[j];
            if (ok[q]) {
                if (layer == 0) {   }
                } }
        if (layer == 1) {
#pragma unroll
            for (int b = 0; b < 2; ++b) {
#pragma unroll
                for (int qq = 0; qq < 2; ++qq) { LAS float* xs = xscr + qq * (32 * 36) + (F.lane >> 3) * 36 + 4 * (F.lane & 7);
#pragma unroll
                    for (int j = 0; j < 4; ++j) *(LAS f32x4*)(xs + 8 * j * 36) = hh[2 * b + qq][j] * MOE_XN_SCALE; }
                LDS_WAIT(); asm volatile("" ::: "memory");
                { const int qq = F.lane >> 5, gi = F.lane & 31; const LAS float* xs = xscr + qq * (32 * 36) + gi * 36; float xv[32];
#pragma unroll
                  for (int c = 0; c < 8; ++c) { const f32x4 t4 = *(const LAS f32x4*)(xs + 4 * c); xv[4 * c] = t4[0]; xv[4 * c + 1] = t4[1]; xv[4 * c + 2] = t4[2]; xv[4 * c + 3] = t4[3]; }
                  const v6u p = pk32_fp6(xv);
                  const int mq = qq ? mm[2 * b + 1] : mm[2 * b]; const bool okq = qq ? ok[2 * b + 1] : ok[2 * b];
                  if (okq) store_f6_group((GAS unsigned char*)XN + (size_t)mq * D, gi, p); }
                LDS_WAIT(); asm volatile("" ::: "memory");
            }
        }
        if (layer == 0) store_rows_i8<NR>((GAS unsigned char*)XN, (GAS float*)(ws + WS_SA), hh, mm, ok, F.lane);
        if (layer == 1) {
            float lg[NR][8];
#pragma unroll
            for (int q = 0; q < NR; ++q)
#pragma unroll
                for (int e = 0; e < 8; ++e) lg[q][e] = 0.f;
#pragma unroll
            for (int j = 0; j < 4; ++j)
#pragma unroll
                for (int c = 0; c < 4; ++c) { const f32x4 wa = rt[((j * 4 + c) * 2) * 64 + F.lane], wb = rt[((j * 4 + c) * 2 + 1) * 64 + F.lane];
#pragma unroll
                    for (int q = 0; q < NR; ++q) { const float y = hh[q][j][c];
                        lg[q][0] += y * wa[0]; lg[q][1] += y * wa[1]; lg[q][2] += y * wa[2]; lg[q][3] += y * wa[3]; lg[q][4] += y * wb[0]; lg[q][5] += y * wb[1]; lg[q][6] += y * wb[2]; lg[q][7] += y * wb[3]; } }
#pragma unroll
            for (int q = 0; q < NR; ++q) wave_sum_n<8>(lg[q]);
#pragma unroll
            for (int q = 0; q < NR; ++q) {
                int e1 = 0; float v1 = lg[q][0];
#pragma unroll
                for (int e = 1; e < 8; ++e) if (lg[q][e] > v1) { v1 = lg[q][e]; e1 = e; }
                int e2 = -1; float v2 = -3.0e38f;
#pragma unroll
                for (int e = 0; e < 8; ++e) if (e != e1 && lg[q][e] > v2) { v2 = lg[q][e]; e2 = e; }
                const float w1 = 1.0f / (1.0f + __expf(v2 - v1)), w2 = 1.0f - w1;
                if (ok[q] && F.lane == 0) { sel[mm[q] - rb0] = (unsigned)e1 | ((unsigned)e2 << 8);
                    GAS float* ti = (GAS float*)(TOKINFO + mm[q]); ti[1] = w1; ti[3] = w2; } }
        }
    }
    if (layer == 1) {
        __syncthreads();
        {
            gu32* ctl = (gu32*)ws; GAS int* INV = (GAS int*)(ws + WS_INV);
            const unsigned e = (unsigned)F.wave; const int nrows = rb1 - rb0;
            int lane_t = F.tid; asm volatile("" : "+v"(lane_t)); lane_t &= 63;
            int cnt = 0;
            for (int r0 = 0; r0 < nrows; r0 += 64) { const int r = r0 + lane_t; const unsigned sl = r < nrows ? sel[r] : 0xffffu;
                cnt += __popcll(__ballot((sl & 0xffu) == e || (sl >> 8) == e)); }
            int base = 0;
            if (cnt > 0 && lane_t == 0) base = (int)__hip_atomic_fetch_add(ctl + CW_CNT + 64 * e, (unsigned)cnt, RLX_AGENT);
            base = __builtin_amdgcn_readfirstlane(base);
            int done = 0;
            for (int r0 = 0; r0 < nrows; r0 += 64) { const int r = r0 + lane_t; const unsigned sl = r < nrows ? sel[r] : 0xffffu;
                const bool a = (sl & 0xffu) == e, b2 = (sl >> 8) == e; const unsigned long long mk = __ballot(a || b2);
                if (a || b2) { const int rank = base + done + (int)__builtin_amdgcn_mbcnt_hi((unsigned)(mk >> 32), __builtin_amdgcn_mbcnt_lo((unsigned)mk, 0u)); INV[e * T + rank] = rb0 + r;
                    GAS unsigned* ti = (GAS unsigned*)(TOKINFO + rb0 + r); ti[a ? 0 : 2] = e | ((unsigned)rank << 4); }
                done += __popcll(mk); }
        }
        __syncthreads();
    }
}
__device__ __forceinline__ void ph_norm_ffn0(const Frame& F_) {
    const Frame F = opaque(F_);
    GAS unsigned char* ws = ka_ptr(KA_WS);
    const gbf16* FB = (const gbf16*)(ka_ptr(KA_OUT) + OUT_MIX); gbf16* XN = WSP(ws, WS_XN);
    GAS _Float16* H16 = (GAS _Float16*)(ws + WS_H16);
    const int gw = F.bid * NWAVES + F.wave, NGW = F.G * NWAVES;
    f32x4 gpost[4], gnx[4]; load_row_f32(ka_in(14), F.lane, gpost); load_row_f32(ka_in(2) + D, F.lane, gnx);
#pragma unroll 1
    for (int m0 = gw; m0 < T; m0 += NR * NGW) {
        f32x4 v[NR][4], hh[NR][4]; int mm[NR]; bool ok[NR];
#pragma unroll
        for (int q = 0; q < NR; ++q) { ok[q] = (m0 + q * NGW < T); mm[q] = ok[q] ? m0 + q * NGW : m0; load_row_bf16(FB + (size_t)mm[q] * D, F.lane, v[q]); load_row_f16(H16 + (size_t)mm[q] * D, F.lane, hh[q]); }
        float ss[NR];
#pragma unroll
        for (int q = 0; q < NR; ++q) ss[q] = row_ssq_local(v[q]);
        wave_sum_n<NR>(ss);
#pragma unroll
        for (int q = 0; q < NR; ++q) { const float r = 1.0f / sqrtf(ss[q] * (1.0f / D) + EPS);
#pragma unroll
            for (int j = 0; j < 4; ++j) hh[q][j] = hh[q][j] + v[q][j] * r * gpost[j];
            if (ok[q]) store_row_f16(H16 + (size_t)mm[q] * D, F.lane, hh[q]);
            ss[q] = row_ssq_local(hh[q]); }
        wave_sum_n<NR>(ss);
#pragma unroll
        for (int q = 0; q < NR; ++q) { const float r2 = 1.0f / sqrtf(ss[q] * (1.0f / D) + EPS);
#pragma unroll
            for (int j = 0; j < 4; ++j) hh[q][j] = hh[q][j] * r2 * gnx[j]; }
        store_rows_i8<NR>((GAS unsigned char*)XN, (GAS float*)(ws + WS_SA), hh, mm, ok, F.lane);
    }
}
__device__ __forceinline__ void ph_final(const Frame& F_) {
    const Frame F = opaque(F_);
    GAS unsigned char* ws = ka_ptr(KA_WS);
    moe_table(F, ws);
    const LAS int* MOETBL = (const LAS int*)(F.lds + MOETBL_OFF);
    const GAS unsigned char* FS8 = ws + WS_FS; const gbf16* FSP = WSP(ws, WS_FSP); const GAS v4u* TOKINFO = (const GAS v4u*)(ws + WS_TOKINFO);
    const GAS _Float16* H16 = (const GAS _Float16*)(ws + WS_H16);
    GAS float* out = (GAS float*)ka_ptr(KA_OUT);
    const int gw = F.bid * NWAVES + F.wave, NGW = F.G * NWAVES;
    f32x4 gpost[4]; load_row_f32(ka_in(14) + D, F.lane, gpost);
    v4u tin[NR];
#pragma unroll
    for (int q = 0; q < NR; ++q) { const int mn = gw + q * NGW; tin[q] = TOKINFO[mn < T ? mn : 0]; }
#pragma unroll 1
    for (int m0 = gw; m0 < T; m0 += NR * NGW) {
        f32x4 a[NR][4], c[NR][4], hh[NR][4]; float w1[NR], w2[NR]; int mm[NR]; bool ok[NR]; v4u ti[NR]; int r1[NR], r2[NR];
#pragma unroll
        for (int q = 0; q < NR; ++q) { ok[q] = (m0 + q * NGW < T); mm[q] = ok[q] ? m0 + q * NGW : m0; ti[q] = tin[q]; }
#pragma unroll
        for (int q = 0; q < NR; ++q) { const int mn = m0 + NR * NGW + q * NGW; tin[q] = TOKINFO[mn < T ? mn : m0]; }
#pragma unroll
        for (int q = 0; q < NR; ++q) {
            const int e1 = (int)(ti[q].x & 15u), k1 = (int)(ti[q].x >> 4), e2 = (int)(ti[q].z & 15u), k2 = (int)(ti[q].z >> 4);
            w1[q] = __uint_as_float(ti[q].y); w2[q] = __uint_as_float(ti[q].w);
            r1[q] = __builtin_amdgcn_readfirstlane(MOETBL[e1] * 256 + k1); r2[q] = __builtin_amdgcn_readfirstlane(MOETBL[e2] * 256 + k2);
            load_row_f16(H16 + (size_t)mm[q] * D, F.lane, hh[q]);
            load_row_fp8(FS8 + (size_t)(r1[q] < 65536 ? r1[q] : 65535) * D, F.lane, a[q]);
            load_row_fp8(FS8 + (size_t)(r2[q] < 65536 ? r2[q] : 65535) * D, F.lane, c[q]); }
        { bool tail = false;
#pragma unroll
          for (int q = 0; q < NR; ++q) tail = tail || r1[q] >= 65536 || r2[q] >= 65536;
          if (tail) {
#pragma unroll
              for (int q = 0; q < NR; ++q) {
                  if (r1[q] >= 65536) { load_row_bf16(FSP + (size_t)(r1[q] - 65536) * D, F.lane, a[q]);
#pragma unroll
                      for (int j = 0; j < 4; ++j) a[q][j] = a[q][j] * MOE_FS_SCALE;
#pragma unroll 1
                      for (int ks = 1; ks < MOE_SPLITK; ++ks) { f32x4 p[4]; load_row_bf16(FSP + (size_t)ks * (MOE_TAIL_TILES * 256 * D) + (size_t)(r1[q] - 65536) * D, F.lane, p);
#pragma unroll
                          for (int j = 0; j < 4; ++j) a[q][j] = a[q][j] + p[j] * MOE_FS_SCALE; } }
                  if (r2[q] >= 65536) { load_row_bf16(FSP + (size_t)(r2[q] - 65536) * D, F.lane, c[q]);
#pragma unroll
                      for (int j = 0; j < 4; ++j) c[q][j] = c[q][j] * MOE_FS_SCALE;
#pragma unroll 1
                      for (int ks = 1; ks < MOE_SPLITK; ++ks) { f32x4 p[4]; load_row_bf16(FSP + (size_t)ks * (MOE_TAIL_TILES * 256 * D) + (size_t)(r2[q] - 65536) * D, F.lane, p);
#pragma unroll
                          for (int j = 0; j < 4; ++j) c[q][j] = c[q][j] + p[j] * MOE_FS_SCALE; } } } } }
        float ss[NR];
#pragma unroll
        for (int q = 0; q < NR; ++q) {
#pragma unroll
            for (int j = 0; j < 4; ++j) a[q][j] = a[q][j] * w1[q] + c[q][j] * w2[q];
            ss[q] = row_ssq_local(a[q]); }
        wave_sum_n<NR>(ss);
#pragma unroll
        for (int q = 0; q < NR; ++q) { const float r = 1.0f / sqrtf(ss[q] * (1.0f / D) + EPS * (MOE_FS_SCALE * MOE_FS_SCALE));
#pragma unroll
            for (int j = 0; j < 4; ++j) hh[q][j] = hh[q][j] + a[q][j] * r * gpost[j];
            if (ok[q]) { GAS f32x4* op = (GAS f32x4*)(out + (size_t)mm[q] * D) + F.lane;
#pragma unroll
                for (int j = 0; j < 4; ++j) __builtin_nontemporal_store(hh[q][j], op + 64 * j); } }
    }
}

__global__ void __launch_bounds__(NWAVES * 64, 2) fwd(Args args) {
    extern __shared__ __attribute__((aligned(16))) unsigned char lds_raw[];
    Frame F;
    F.lds = (LAS unsigned char*)lds_raw;
    F.tid = threadIdx.x; F.lane = F.tid & 63; F.wave = __builtin_amdgcn_readfirstlane(F.tid >> 6);
    F.G = gridDim.x; F.bid = blockIdx.x;
    for (int u = F.tid; u < (LDS_BYTES - LDSCTL_OFF) / 4; u += NWAVES * 64) ((LAS unsigned*)(F.lds + LDSCTL_OFF))[u] = 0u;
    __syncthreads();
    if (!MK_PER_PHASE_LAUNCH) (void)xcd_barrier_post((unsigned*)((gu32*)ka_ptr(KA_WS) + CW_BAR), (volatile LAS unsigned*)(F.lds + MISC_OFF) + 8);

    const int lo = ka_int(KA_LO), hi = ka_int(KA_HI);
    int ph = 0;
#define PH_ON (lo <= ph && ph < hi)
#define PH_END do { if (PH_ON && ph + 1 < hi) { if (!MK_PER_PHASE_LAUNCH) { XcdBarrier bar; bar.bar = (unsigned*)((gu32*)ka_ptr(KA_WS) + CW_BAR); bar.x = xb_xcc_id(); bar.st = (volatile LAS unsigned*)(F.lds + MISC_OFF) + 8; xcd_barrier(bar); } } ++ph; } while (0)

    if (PH_ON) ph_prologue(F);
    PH_END;
    for (int layer = 0; layer < DEPTH; ++layer) {
        if (PH_ON) ph_gemm_in(F, layer);
        PH_END;
        if (PH_ON) ph_mixer(F, layer);
        PH_END;
        if (PH_ON) ph_gemm_out(F, layer);
        PH_END;
        if (PH_ON) { if (layer == 0) ph_norm_mix<0>(F); else ph_norm_mix<1>(F); }
        PH_END;
        if (layer == 0) {
            if (PH_ON) ph_gemm_gu(F);
            PH_END;
            if (PH_ON) ph_gemm_down(F);
            PH_END;
            if (PH_ON) ph_norm_ffn0(F);
            PH_END;
        } else {
            if (PH_ON) ph_moe_gu(F);
            PH_END;
            if (PH_ON) ph_moe_down(F);
            PH_END;
            if (PH_ON) ph_final(F);
            PH_END;
        }
    }
#undef PH_ON
#undef PH_END
}
constexpr int N_PHASES = 1 + 2 * 4 + 3 + 2 + 1;

extern "C" void kernel_launch(void* const* d_in, const int* in_sizes, int n_in, void* d_out, int out_size, void* d_ws, size_t ws_size, hipStream_t stream) {
    static int grid = 0;
    if (grid == 0) {
        if (n_in != 22 || out_size != T * D || ws_size < WS_END) { fprintf(stderr, "kernel_launch: unexpected shapes (n_in %d, out %d, ws %zu); nothing launched\n", n_in, out_size, ws_size); grid = -1; return; }
        int dev = 0, cus = 0, per_cu = 0;
        if (hipGetDevice(&dev) != hipSuccess || hipDeviceGetAttribute(&cus, hipDeviceAttributeMultiprocessorCount, dev) != hipSuccess) { grid = -1; return; }
        if (hipFuncSetAttribute((const void*)fwd, hipFuncAttributeMaxDynamicSharedMemorySize, LDS_BYTES) != hipSuccess) { fprintf(stderr, "kernel_launch: hipFuncSetAttribute failed\n"); grid = -1; return; }
        if (hipOccupancyMaxActiveBlocksPerMultiprocessor(&per_cu, (const void*)fwd, NWAVES * 64, LDS_BYTES) != hipSuccess || per_cu < 1)
            fprintf(stderr, "kernel_launch: occupancy query reports %d workgroups per CU\n", per_cu);
        (void)hipGetLastError();
        grid = cus;
    }
    if (grid < 0) return;
    if (hipMemsetAsync((char*)d_ws + WS_CTL, 0, CTL_ZERO_BYTES, stream) != hipSuccess) return;
    Args a{};
    for (int i = 0; i < 22; ++i) a.in[i] = d_in[i];
    a.out = (float*)d_out; a.ws = (unsigned char*)d_ws;
#if MK_PER_PHASE_LAUNCH
    for (int p = 0; p < N_PHASES; ++p) { a.ph_lo = p; a.ph_hi = p + 1; hipLaunchKernelGGL(fwd, dim3(grid), dim3(NWAVES * 64), LDS_BYTES, stream, a); }
#else
    a.ph_lo = 0; a.ph_hi = N_PHASES;
    hipLaunchKernelGGL(fwd, dim3(grid), dim3(NWAVES * 64), LDS_BYTES, stream, a);
#endif
}
```

```cpp
#include <hip/hip_runtime.h>
#include <cstdio>
#include <cstdint>

#ifndef MK_PER_PHASE_LAUNCH
#define MK_PER_PHASE_LAUNCH 0
#endif

#define GAS __attribute__((address_space(1)))
#define LAS __attribute__((address_space(3)))

constexpr int BATCH = 8, SEQ = 4096, D = 1024, DEPTH = 2;
constexpr int T = BATCH * SEQ;
constexpr int HD = 64, NQH = 8, NKVH = 2;
constexpr int ATTW = 512, KVW = 128, SGUW = 512, INW = 1792;
constexpr int BLK = 128;
constexpr int FFD = 2816, FFE = 3584, NEXP = 8;
constexpr float EPS = 1e-6f;
constexpr int ZQ = 0, ZK = 512, ZV = 640, ZU = 768, ZVV = 1280;
constexpr int MOE_CHUNK = 128;
constexpr int MOE_MAXT = 264;
constexpr int MOE_NCHUNK = 2;
constexpr int MOE_SPLITK = 7, MOE_TAIL_TILES = 8;
constexpr float MOE_XN_SCALE = 2.f;
constexpr float MOE_WG_SCALE = -32.f * 1.4426950408889634f, MOE_WU_SCALE = -16.f * 0.6931471805599453f * 4.f  ;
constexpr float MOE_FS_SCALE = 16.f;
constexpr float MOE_WGU_SCALE = 64.f, MOE_WD_SCALE = 128.f, MOE_HID_SCALE = 4.f;
constexpr float WOUT_SCALE = 64.f, WD_SCALE = 128.f, MERGED_SCALE = 4.f, HID_SCALE = 4.f;
constexpr unsigned E8M0_ONE = 0x7f7f7f7fu, E8M0_WGU = 0x79797979u  , E8M0_WD = 0x78787878u  , E8M0_HID = 0x7d7d7d7du  ;

namespace pg8 {
typedef unsigned short bf16_t;
typedef short bf16x8 __attribute__((ext_vector_type(8)));
typedef float f32x4 __attribute__((ext_vector_type(4)));
typedef unsigned u32x4 __attribute__((ext_vector_type(4)));
typedef int i32x4v __attribute__((ext_vector_type(4)));
constexpr int BM = 256, BK = 64, HALF = 128, HTB = HALF * BK * 2, STAGE_BYTES = 8 * HTB, NXCD = 8, WGM = 8;

__host__ __device__ __forceinline__ int lds_byte(int r, int c) { const int st = (r >> 4) * 2 + (c >> 5), rr = r & 15, cc = c & 31, ob = rr * 64 + cc * 2; return st * 1024 + (ob ^ (((ob >> 9) & 1) << 5)); }
__host__ __device__ __forceinline__ void stage_rc(int b, int& R, int& C) { const int st = b / 1024, sb = b % 1024, swz = sb ^ (((sb >> 9) & 1) << 5); R = (st >> 1) * 16 + swz / 64; C = (st & 1) * 32 + (swz % 64) / 2; }
__host__ __device__ __forceinline__ int perm32(int rho) { const int n = rho >> 4, i = rho & 15; return 8 * (i >> 2) + 4 * n + (i & 3); }

struct Unit { int pm, pn, aux; };
typedef GAS bf16_t gbf; typedef const GAS char* gcp;
struct Gemm { const gbf* A; const gbf* Bt; int K; unsigned sa, sb; int nt; unsigned sb1 = 0u; };

struct TileOrder {
    int nM, nN, nwg, G, c;
    __device__ __forceinline__ void init(int nM_, int nN_, int G_, int c_) { nM = nM_; nN = nN_; nwg = nM_ * nN_; G = G_; c = c_; }
    __device__ __forceinline__ bool next(int i, Unit& u) const {
        const long L = (long)i * G + c; if (L >= nwg) return false;
        int wgid = (int)L; { const int q = nwg / NXCD, r = nwg % NXCD, xcd = wgid % NXCD, off = wgid / NXCD; wgid = (xcd < r ? xcd * (q + 1) : r * (q + 1) + (xcd - r) * q) + off; }
        const int nig = WGM * nN, gid = wgid / nig, fm = gid * WGM, gsz = (nM - fm) < WGM ? (nM - fm) : WGM;
        u.pm = fm + ((wgid % nig) % gsz); u.pn = (wgid % nig) / gsz; u.aux = 0; return true;
    }
};
struct DenseSched : TileOrder {
    size_t gapA = 0;
    __device__ __forceinline__ gcp a_base(const Gemm& g, const Unit& u) const { return (gcp)g.A + (size_t)u.pm * ((size_t)BM * g.K * 2) + (size_t)(u.pm >> 4) * gapA; }
    __device__ __forceinline__ gcp b_base(const Gemm& g, const Unit& u) const { return (gcp)g.Bt + (size_t)u.pn * ((size_t)BM * g.K * 2); }
    __device__ __forceinline__ int row(int, int) const { return 0; }
};
struct MoeSched : TileOrder {
    int pm0; const LAS int* tbl; const GAS int* inv; size_t estride;
    const LAS unsigned short* rowtab;
    gcp a1; int split;
    __device__ __forceinline__ bool next(int i, Unit& u) const { if (!TileOrder::next(i, u)) return false; u.pm += pm0; return true; }
    __device__ __forceinline__ int expert(int pm) const { int e = 0;
#pragma unroll
        for (int k = 1; k < 8; ++k) e += (pm >= tbl[k]) ? 1 : 0; return e; }
    __device__ __forceinline__ gcp a_base(const Gemm& g, const Unit& u) const { const size_t ts = (size_t)BM * g.K * 2; return u.pm < split ? (gcp)g.A + (size_t)u.pm * ts : a1 + (size_t)(u.pm - split) * ts; }
    __device__ __forceinline__ gcp b_base(const Gemm& g, const Unit& u) const { return (gcp)g.Bt + (size_t)expert(u.pm) * estride + (size_t)u.pn * ((size_t)BM * g.K * 2); }
    __device__ __forceinline__ int lookup(const Unit& u, int r) const {
        const int e = expert(u.pm), local = (u.pm - tbl[e]) * BM + r;
        return local < tbl[16 + e] ? inv[e * T + local] : 0; }
    __device__ __forceinline__ int row(int i, int r) const { return (int)rowtab[i * 256 + r]; }
};
struct MoeTailSched {
    int nunits, G, c, pm0a; const LAS int* tbl; size_t estride; int nks;
    __device__ __forceinline__ bool next(int i, Unit& u) const { const int L = i * G + c; if (L >= nunits) return false; u.aux = L % nks; const int q = L / nks; u.pn = q & 3; u.pm = 256 + (q >> 2); return true; }
    __device__ __forceinline__ int expert(int pm) const { int e = 0;
#pragma unroll
        for (int k = 1; k < 8; ++k) e += (pm >= tbl[k]) ? 1 : 0; return e; }
    __device__ __forceinline__ gcp a_base(const Gemm& g, const Unit& u) const { return (gcp)g.A + (size_t)(u.pm - pm0a) * ((size_t)BM * g.K * 2) + (size_t)u.aux * 512; }
    __device__ __forceinline__ gcp b_base(const Gemm& g, const Unit& u) const { return (gcp)g.Bt + (size_t)expert(u.pm) * estride + (size_t)u.pn * ((size_t)BM * g.K * 2) + (size_t)u.aux * 512; }
    __device__ __forceinline__ int row(int, int) const { return 0; }
};

__device__ __forceinline__ unsigned cvt_pk_bf16(float lo, float hi) { unsigned r; asm volatile("v_cvt_pk_bf16_f32 %0, %1, %2" : "=v"(r) : "v"(lo), "v"(hi)); return r; }

struct EpiStore {
    static constexpr bool PERM = true;
    gbf* O; int ldc; int pm_off; size_t aux_stride;
    __device__ __forceinline__ void operator()(const f32x4 (&acc)[2][2][4][2], const Unit& u, int wr, int wc, int fr, int fq) const {
        const int row0 = (u.pm - pm_off) * BM + wr * 64 + fr, col0 = u.pn * BM + wc * 32 + 8 * fq;
#pragma unroll
        for (int ai = 0; ai < 2; ++ai)
#pragma unroll
            for (int m = 0; m < 4; ++m) { gbf* rowp = O + (size_t)u.aux * aux_stride + (size_t)(row0 + ai * HALF + m * 16) * ldc + col0;
#pragma unroll
                for (int bj = 0; bj < 2; ++bj) { const f32x4 v0 = acc[ai][bj][m][0], v1 = acc[ai][bj][m][1];
                    u32x4 w; w.x = cvt_pk_bf16(v0[0], v0[1]); w.y = cvt_pk_bf16(v0[2], v0[3]); w.z = cvt_pk_bf16(v1[0], v1[1]); w.w = cvt_pk_bf16(v1[2], v1[3]);
                    *(GAS u32x4*)(rowp + bj * HALF) = w; } }
    }
};
__device__ __forceinline__ float silu_f(float x) { return x * __builtin_amdgcn_rcpf(1.0f + __builtin_amdgcn_exp2f(-1.4426950408889634f * x)); }
struct EpiStore8 {
    static constexpr bool PERM = true;
    GAS unsigned char* O; int ldc; int pm_off; float oscale;
    __device__ __forceinline__ unsigned pk4(f32x4 v) const {
        const float a = __builtin_amdgcn_fmed3f(v[0] * oscale, -448.f, 448.f), b = __builtin_amdgcn_fmed3f(v[1] * oscale, -448.f, 448.f), c = __builtin_amdgcn_fmed3f(v[2] * oscale, -448.f, 448.f), d = __builtin_amdgcn_fmed3f(v[3] * oscale, -448.f, 448.f);
        int w = __builtin_amdgcn_cvt_pk_fp8_f32(a, b, 0, false); w = __builtin_amdgcn_cvt_pk_fp8_f32(c, d, w, true); return (unsigned)w; }
    __device__ __forceinline__ void operator()(const f32x4 (&acc)[2][2][4][2], const Unit& u, int wr, int wc, int fr, int fq) const {
        typedef unsigned u32x2 __attribute__((ext_vector_type(2)));
        const int row0 = (u.pm - pm_off) * BM + wr * 64 + fr, col0 = u.pn * BM + wc * 32 + 8 * fq;
#pragma unroll
        for (int ai = 0; ai < 2; ++ai)
#pragma unroll
            for (int m = 0; m < 4; ++m) { GAS unsigned char* rowp = O + (size_t)(row0 + ai * HALF + m * 16) * ldc + col0;
#pragma unroll
                for (int bj = 0; bj < 2; ++bj) { u32x2 w; w.x = pk4(acc[ai][bj][m][0]); w.y = pk4(acc[ai][bj][m][1]); *(GAS u32x2*)(rowp + bj * HALF) = w; } }
    }
};
struct EpiSwiGLU {
    static constexpr bool PERM = true;
    gbf* O; int ldc; int pm_off;
    __device__ __forceinline__ void operator()(const f32x4 (&acc)[2][2][4][2], const Unit& u, int wr, int wc, int fr, int fq) const {
        const int row0 = (u.pm - pm_off) * BM + wr * 64 + fr, col0 = u.pn * HALF + wc * 32 + 8 * fq;
#pragma unroll
        for (int ai = 0; ai < 2; ++ai)
#pragma unroll
            for (int m = 0; m < 4; ++m) { gbf* rowp = O + (size_t)(row0 + ai * HALF + m * 16) * ldc + col0;
                const f32x4 g0 = acc[ai][0][m][0], g1 = acc[ai][0][m][1], u0 = acc[ai][1][m][0], u1 = acc[ai][1][m][1];
                u32x4 w; w.x = cvt_pk_bf16(silu_f(g0[0]) * u0[0], silu_f(g0[1]) * u0[1]); w.y = cvt_pk_bf16(silu_f(g0[2]) * u0[2], silu_f(g0[3]) * u0[3]);
                w.z = cvt_pk_bf16(silu_f(g1[0]) * u1[0], silu_f(g1[1]) * u1[1]); w.w = cvt_pk_bf16(silu_f(g1[2]) * u1[2], silu_f(g1[3]) * u1[3]);
                *(GAS u32x4*)rowp = w; }
    }
};

struct EpiStoreq {
    static constexpr bool PERM = true;
    gbf* O; int ldc; int pm_off; const GAS float* sa; const GAS float* sw;
    __device__ __forceinline__ void operator()(const f32x4 (&acc)[2][2][4][2], const Unit& u, int wr, int wc, int fr, int fq) const {
        const int row0 = (u.pm - pm_off) * BM + wr * 64 + fr, col0 = u.pn * BM + wc * 32 + 8 * fq;
        f32x4 sc[2][2];
#pragma unroll
        for (int bj = 0; bj < 2; ++bj)
#pragma unroll
            for (int n = 0; n < 2; ++n) sc[bj][n] = *(const GAS f32x4*)(sw + col0 + bj * HALF + 4 * n);
        float sar[2][4];
#pragma unroll
        for (int ai = 0; ai < 2; ++ai)
#pragma unroll
            for (int m = 0; m < 4; ++m) sar[ai][m] = sa[row0 + ai * HALF + m * 16];
#pragma unroll
        for (int ai = 0; ai < 2; ++ai)
#pragma unroll
            for (int m = 0; m < 4; ++m) { gbf* rowp = O + (size_t)(row0 + ai * HALF + m * 16) * ldc + col0; const float sr = sar[ai][m];
#pragma unroll
                for (int bj = 0; bj < 2; ++bj) { const i32x4v i0 = __builtin_bit_cast(i32x4v, acc[ai][bj][m][0]), i1 = __builtin_bit_cast(i32x4v, acc[ai][bj][m][1]);
                    f32x4 v0, v1;
#pragma unroll
                    for (int j = 0; j < 4; ++j) { v0[j] = (float)i0[j] * (sr * sc[bj][0][j]); v1[j] = (float)i1[j] * (sr * sc[bj][1][j]); }
                    u32x4 w; w.x = cvt_pk_bf16(v0[0], v0[1]); w.y = cvt_pk_bf16(v0[2], v0[3]); w.z = cvt_pk_bf16(v1[0], v1[1]); w.w = cvt_pk_bf16(v1[2], v1[3]);
                    *(GAS u32x4*)(rowp + bj * HALF) = w; } }
    }
};
struct EpiSwiGLUq {
    static constexpr bool PERM = true;
    gbf* O; int ldc; int pm_off; const GAS float* sa; const GAS float* sw;
    __device__ __forceinline__ void operator()(const f32x4 (&acc)[2][2][4][2], const Unit& u, int wr, int wc, int fr, int fq) const {
        const int row0 = (u.pm - pm_off) * BM + wr * 64 + fr, col0 = u.pn * HALF + wc * 32 + 8 * fq, bcol0 = u.pn * BM + wc * 32 + 8 * fq;
        const f32x4 sg0 = *(const GAS f32x4*)(sw + bcol0), sg1 = *(const GAS f32x4*)(sw + bcol0 + 4), su0 = *(const GAS f32x4*)(sw + bcol0 + HALF), su1 = *(const GAS f32x4*)(sw + bcol0 + HALF + 4);
        float sar[2][4];
#pragma unroll
        for (int ai = 0; ai < 2; ++ai)
#pragma unroll
            for (int m = 0; m < 4; ++m) sar[ai][m] = sa[row0 + ai * HALF + m * 16];
#pragma unroll
        for (int ai = 0; ai < 2; ++ai)
#pragma unroll
            for (int m = 0; m < 4; ++m) { gbf* rowp = O + (size_t)(row0 + ai * HALF + m * 16) * ldc + col0; const float sr = sar[ai][m];
                const i32x4v ig0 = __builtin_bit_cast(i32x4v, acc[ai][0][m][0]), ig1 = __builtin_bit_cast(i32x4v, acc[ai][0][m][1]), iu0 = __builtin_bit_cast(i32x4v, acc[ai][1][m][0]), iu1 = __builtin_bit_cast(i32x4v, acc[ai][1][m][1]);
                f32x4 g0, g1, u0, u1;
#pragma unroll
                for (int j = 0; j < 4; ++j) { g0[j] = (float)ig0[j] * (sr * sg0[j]); g1[j] = (float)ig1[j] * (sr * sg1[j]); u0[j] = (float)iu0[j] * (sr * su0[j]); u1[j] = (float)iu1[j] * (sr * su1[j]); }
                u32x4 w; w.x = cvt_pk_bf16(silu_f(g0[0]) * u0[0], silu_f(g0[1]) * u0[1]); w.y = cvt_pk_bf16(silu_f(g0[2]) * u0[2], silu_f(g0[3]) * u0[3]);
                w.z = cvt_pk_bf16(silu_f(g1[0]) * u1[0], silu_f(g1[1]) * u1[1]); w.w = cvt_pk_bf16(silu_f(g1[2]) * u1[2], silu_f(g1[3]) * u1[3]);
                __builtin_nontemporal_store(w, (GAS u32x4*)rowp); }
    }
};
struct EpiSwiGLUq8 {
    static constexpr bool PERM = true;
    GAS unsigned char* O; int ldc; int pm_off; const GAS float* sa; const GAS float* sw; float oscale; size_t gap;
    __device__ __forceinline__ unsigned pk4(float a, float b, float c, float d) const {
        a = __builtin_amdgcn_fmed3f(a * oscale, -448.f, 448.f); b = __builtin_amdgcn_fmed3f(b * oscale, -448.f, 448.f); c = __builtin_amdgcn_fmed3f(c * oscale, -448.f, 448.f); d = __builtin_amdgcn_fmed3f(d * oscale, -448.f, 448.f);
        int w = __builtin_amdgcn_cvt_pk_fp8_f32(a, b, 0, false); w = __builtin_amdgcn_cvt_pk_fp8_f32(c, d, w, true); return (unsigned)w; }
    __device__ __forceinline__ void operator()(const f32x4 (&acc)[2][2][4][2], const Unit& u, int wr, int wc, int fr, int fq) const {
        typedef unsigned u32x2 __attribute__((ext_vector_type(2)));
        const int row0 = (u.pm - pm_off) * BM + wr * 64 + fr, col0 = u.pn * HALF + wc * 32 + 8 * fq, bcol0 = u.pn * BM + wc * 32 + 8 * fq;
        const f32x4 sg0 = *(const GAS f32x4*)(sw + bcol0), sg1 = *(const GAS f32x4*)(sw + bcol0 + 4), su0 = *(const GAS f32x4*)(sw + bcol0 + HALF), su1 = *(const GAS f32x4*)(sw + bcol0 + HALF + 4);
        float sar[2][4];
#pragma unroll
        for (int ai = 0; ai < 2; ++ai)
#pragma unroll
            for (int m = 0; m < 4; ++m) sar[ai][m] = sa[row0 + ai * HALF + m * 16];
#pragma unroll
        for (int ai = 0; ai < 2; ++ai)
#pragma unroll
            for (int m = 0; m < 4; ++m) { GAS unsigned char* rowp = O + (size_t)(u.pm >> 4) * gap + (size_t)(row0 + ai * HALF + m * 16) * ldc + col0; const float sr = sar[ai][m];
                const i32x4v ig0 = __builtin_bit_cast(i32x4v, acc[ai][0][m][0]), ig1 = __builtin_bit_cast(i32x4v, acc[ai][0][m][1]), iu0 = __builtin_bit_cast(i32x4v, acc[ai][1][m][0]), iu1 = __builtin_bit_cast(i32x4v, acc[ai][1][m][1]);
                f32x4 g0, g1, u0, u1;
#pragma unroll
                for (int j = 0; j < 4; ++j) { g0[j] = (float)ig0[j] * (sr * sg0[j]); g1[j] = (float)ig1[j] * (sr * sg1[j]); u0[j] = (float)iu0[j] * (sr * su0[j]); u1[j] = (float)iu1[j] * (sr * su1[j]); }
                u32x2 w; w.x = pk4(silu_f(g0[0]) * u0[0], silu_f(g0[1]) * u0[1], silu_f(g0[2]) * u0[2], silu_f(g0[3]) * u0[3]);
                w.y = pk4(silu_f(g1[0]) * u1[0], silu_f(g1[1]) * u1[1], silu_f(g1[2]) * u1[2], silu_f(g1[3]) * u1[3]);
                *(GAS u32x2*)rowp = w; }
    }
};
struct EpiSwiGLU8p {
    static constexpr bool PERM = true;
    GAS unsigned char* O; GAS unsigned char* O1; int split; int ldc;
    __device__ __forceinline__ float h1(float t, float u) const { return __builtin_amdgcn_fmed3f((t * u) * __builtin_amdgcn_rcpf(1.0f + __builtin_amdgcn_exp2f(t)), -448.f, 448.f); }
    __device__ __forceinline__ unsigned pk4(float a, float b, float c, float d) const { int w = __builtin_amdgcn_cvt_pk_fp8_f32(a, b, 0, false); w = __builtin_amdgcn_cvt_pk_fp8_f32(c, d, w, true); return (unsigned)w; }
    __device__ __forceinline__ void operator()(const f32x4 (&acc)[2][2][4][2], const Unit& u, int wr, int wc, int fr, int fq) const {
        typedef unsigned u32x2 __attribute__((ext_vector_type(2)));
        GAS unsigned char* Ob = u.pm < split ? O : O1;
        const int row0 = (u.pm < split ? u.pm : u.pm - split) * BM + wr * 64 + fr, col0 = u.pn * HALF + wc * 32 + 8 * fq;
#pragma unroll
        for (int ai = 0; ai < 2; ++ai)
#pragma unroll
            for (int m = 0; m < 4; ++m) { GAS unsigned char* rowp = Ob + (size_t)(row0 + ai * HALF + m * 16) * ldc + col0;
                const f32x4 g0 = acc[ai][0][m][0], g1 = acc[ai][0][m][1], u0 = acc[ai][1][m][0], u1 = acc[ai][1][m][1];
                u32x2 w; w.x = pk4(h1(g0[0], u0[0]), h1(g0[1], u0[1]), h1(g0[2], u0[2]), h1(g0[3], u0[3]));
                w.y = pk4(h1(g1[0], u1[0]), h1(g1[1], u1[1]), h1(g1[2], u1[2]), h1(g1[3], u1[3]));
                __builtin_nontemporal_store(w, (GAS u32x2*)rowp); }
    }
};
struct EpiSwiGLU8 {
    static constexpr bool PERM = true;
    GAS unsigned char* O; GAS unsigned char* O1; int split; int ldc; float oscale;
    __device__ __forceinline__ unsigned pk4(float a, float b, float c, float d) const {
        a = __builtin_amdgcn_fmed3f(a * oscale, -448.f, 448.f); b = __builtin_amdgcn_fmed3f(b * oscale, -448.f, 448.f); c = __builtin_amdgcn_fmed3f(c * oscale, -448.f, 448.f); d = __builtin_amdgcn_fmed3f(d * oscale, -448.f, 448.f);
        int w = __builtin_amdgcn_cvt_pk_fp8_f32(a, b, 0, false); w = __builtin_amdgcn_cvt_pk_fp8_f32(c, d, w, true); return (unsigned)w; }
    __device__ __forceinline__ void operator()(const f32x4 (&acc)[2][2][4][2], const Unit& u, int wr, int wc, int fr, int fq) const {
        typedef unsigned u32x2 __attribute__((ext_vector_type(2)));
        GAS unsigned char* Ob = u.pm < split ? O : O1;
        const int row0 = (u.pm < split ? u.pm : u.pm - split) * BM + wr * 64 + fr, col0 = u.pn * HALF + wc * 32 + 8 * fq;
#pragma unroll
        for (int ai = 0; ai < 2; ++ai)
#pragma unroll
            for (int m = 0; m < 4; ++m) { GAS unsigned char* rowp = Ob + (size_t)(row0 + ai * HALF + m * 16) * ldc + col0;
                const f32x4 g0 = acc[ai][0][m][0], g1 = acc[ai][0][m][1], u0 = acc[ai][1][m][0], u1 = acc[ai][1][m][1];
                u32x2 w; w.x = pk4(silu_f(g0[0]) * u0[0], silu_f(g0[1]) * u0[1], silu_f(g0[2]) * u0[2], silu_f(g0[3]) * u0[3]);
                w.y = pk4(silu_f(g1[0]) * u1[0], silu_f(g1[1]) * u1[1], silu_f(g1[2]) * u1[2], silu_f(g1[3]) * u1[3]);
                __builtin_nontemporal_store(w, (GAS u32x2*)rowp); }
    }
};

typedef int i32x8 __attribute__((ext_vector_type(8))); typedef int i32x4v __attribute__((ext_vector_type(4))); typedef int i32x6 __attribute__((ext_vector_type(6))); typedef int i32x2v __attribute__((ext_vector_type(2)));
__device__ __forceinline__ i32x6 cat6(i32x4v x, i32x2v y) { return __builtin_shufflevector(__builtin_shufflevector(x, x, 0, 1, 2, 3, -1, -1), __builtin_shufflevector(y, y, 0, 1, -1, -1, -1, -1), 0, 1, 2, 3, 6, 7); }
__device__ __forceinline__ i32x8 cat8(bf16x8 a, bf16x8 b) { const i32x4v x = __builtin_bit_cast(i32x4v, a), y = __builtin_bit_cast(i32x4v, b); return __builtin_shufflevector(x, y, 0, 1, 2, 3, 4, 5, 6, 7); }
template <class Epi, class Sched, bool GATHER, int MODE = 0  >
__device__ __forceinline__ void gemm_phase(LAS unsigned char* lds, const Gemm g, const Sched& S, const Epi& E) {
    int tid_ = threadIdx.x; asm volatile("" : "+v"(tid_));
    const int tid = tid_, wid = __builtin_amdgcn_readfirstlane(tid >> 6), lane = tid & 63, wr = wid >> 2, wc = wid & 3, fr = lane & 15, fq = lane >> 4;
    int K_ = g.K; asm volatile("" : "+s"(K_));
    const int K = K_, nt = g.nt ? g.nt : K / BK;
    unsigned voffB[2]; int Rr[2], Cc[2];
#pragma unroll
    for (int i = 0; i < 2; ++i) { int R, C; stage_rc(tid * 16 + i * 8192, R, C); const int Rb = Epi::PERM ? ((R & ~31) + perm32(R & 31)) : R;
        voffB[i] = (unsigned)(Rb * K + C) * 2u; Rr[i] = R; Cc[i] = C; }
    const size_t kstep = (size_t)(BK * 2);
    const size_t hstep = (size_t)HALF * K * 2;
    const unsigned ldsw = (unsigned)wid * 1024u;
    const int aoff = lds_byte(wr * 64 + fr, fq * 8), boff = lds_byte(wc * 32 + fr, fq * 8);
#define PG8_SA(b, h) (((b) * 2 + (h)) * HTB)
#define PG8_SB(b, h) ((4 + (b) * 2 + (h)) * HTB)
#define PG8_STAGE(bufoff, gbase, voff) do { _Pragma("unroll") for (int _i = 0; _i < 2; ++_i) \
        __builtin_amdgcn_global_load_lds((const GAS unsigned*)((gcp)(gbase) + (voff)[_i]), (LAS unsigned*)(lds + (bufoff) + ldsw + _i * 8192), 16, 0, 0); } while (0)
#define PG8_LDA(dst, b, h) do { _Pragma("unroll") for (int m = 0; m < 4; ++m) { if constexpr (MODE == 0 || MODE == 2) { _Pragma("unroll") for (int k = 0; k < 2; ++k) dst[m][k] = *(const LAS bf16x8*)(lds + PG8_SA(b, h) + aoff + m * 2048 + k * 1024); } \
        else if constexpr (MODE == 1) dst##8[m] = cat8(*(const LAS bf16x8*)(lds + PG8_SA(b, h) + aoff + m * 2048), *(const LAS bf16x8*)(lds + PG8_SA(b, h) + aoff + m * 2048 + 1024)); \
        else dst##6[m] = cat6(*(const LAS i32x4v*)(lds + PG8_SA(b, h) + aoff + m * 2048), *(const volatile LAS i32x2v*)(lds + PG8_SA(b, h) + aoff + m * 2048 + 1024)); } } while (0)
#define PG8_LDB(dst, b, h) do { _Pragma("unroll") for (int n = 0; n < 2; ++n) { if constexpr (MODE == 0 || MODE == 2) { _Pragma("unroll") for (int k = 0; k < 2; ++k) dst[n][k] = *(const LAS bf16x8*)(lds + PG8_SB(b, h) + boff + n * 2048 + k * 1024); } \
        else if constexpr (MODE == 1) dst##8[n] = cat8(*(const LAS bf16x8*)(lds + PG8_SB(b, h) + boff + n * 2048), *(const LAS bf16x8*)(lds + PG8_SB(b, h) + boff + n * 2048 + 1024)); \
        else dst##6[n] = cat6(*(const LAS i32x4v*)(lds + PG8_SB(b, h) + boff + n * 2048), *(const volatile LAS i32x2v*)(lds + PG8_SB(b, h) + boff + n * 2048 + 1024)); } } while (0)
#define PG8_MMA(ai, bj, At, Bt) do { __builtin_amdgcn_s_setprio(1); _Pragma("unroll") for (int m = 0; m < 4; ++m) _Pragma("unroll") for (int n = 0; n < 2; ++n) { \
        if constexpr (MODE == 0) { _Pragma("unroll") for (int k = 0; k < 2; ++k) acc[ai][bj][m][n] = __builtin_amdgcn_mfma_f32_16x16x32_bf16(Bt[n][k], At[m][k], acc[ai][bj][m][n], 0, 0, 0); } \
        else if constexpr (MODE == 2) { _Pragma("unroll") for (int k = 0; k < 2; ++k) acc[ai][bj][m][n] = __builtin_bit_cast(f32x4, __builtin_amdgcn_mfma_i32_16x16x64_i8(__builtin_bit_cast(i32x4v, Bt[n][k]), __builtin_bit_cast(i32x4v, At[m][k]), __builtin_bit_cast(i32x4v, acc[ai][bj][m][n]), 0, 0, 0)); } \
        else if constexpr (MODE == 1) asm volatile("v_mfma_scale_f32_16x16x128_f8f6f4 %0, %1, %2, %0, %3, %4 op_sel_hi:[0,0,0]" : "+v"(acc[ai][bj][m][n]) : "v"(Bt##8[n]), "v"(At##8[m]), "v"(vsb), "v"(vsa)); \
        else asm volatile("v_mfma_scale_f32_16x16x128_f8f6f4 %0, %1, %2, %0, %3, %4 op_sel_hi:[0,0,0] cbsz:2 blgp:2" : "+v"(acc[ai][bj][m][n]) : "v"(Bt##6[n]), "v"(At##6[m]), "v"((bj) ? vsb1 : vsb), "v"(vsa)); } \
        __builtin_amdgcn_s_setprio(0); } while (0)
#define PG8_MMA0(ai, bj, At, Bt) do { __builtin_amdgcn_s_setprio(1); _Pragma("unroll") for (int m = 0; m < 4; ++m) _Pragma("unroll") for (int n = 0; n < 2; ++n) { \
        if constexpr (MODE == 0) { acc[ai][bj][m][n] = __builtin_amdgcn_mfma_f32_16x16x32_bf16(Bt[n][0], At[m][0], (f32x4){0.f, 0.f, 0.f, 0.f}, 0, 0, 0); \
                                   acc[ai][bj][m][n] = __builtin_amdgcn_mfma_f32_16x16x32_bf16(Bt[n][1], At[m][1], acc[ai][bj][m][n], 0, 0, 0); } \
        else if constexpr (MODE == 1) asm volatile("v_mfma_scale_f32_16x16x128_f8f6f4 %0, %1, %2, 0, %3, %4 op_sel_hi:[0,0,0]" : "=&v"(acc[ai][bj][m][n]) : "v"(Bt##8[n]), "v"(At##8[m]), "v"(vsb), "v"(vsa)); \
        else asm volatile("v_mfma_scale_f32_16x16x128_f8f6f4 %0, %1, %2, 0, %3, %4 op_sel_hi:[0,0,0] cbsz:2 blgp:2" : "=&v"(acc[ai][bj][m][n]) : "v"(Bt##6[n]), "v"(At##6[m]), "v"((bj) ? vsb1 : vsb), "v"(vsa)); } \
        __builtin_amdgcn_s_setprio(0); } while (0)
#define PG8_WAIT_V(n) asm volatile("s_waitcnt vmcnt(" #n ")" ::: "memory")
#define PG8_WAIT_L(n) asm volatile("s_waitcnt lgkmcnt(" #n ")" ::: "memory")
#define PG8_BAR __builtin_amdgcn_s_barrier()
#define PG8_SCHED __builtin_amdgcn_sched_barrier(0)
#define PG8_AOFF(v, ui_) do { _Pragma("unroll") for (int _h = 0; _h < 2; ++_h) _Pragma("unroll") for (int _i = 0; _i < 2; ++_i) { \
        const int _row = S.row(ui_, _h * HALF + Rr[_i]); v[_h][_i] = (unsigned)(_row * K + Cc[_i]) * 2u; } } while (0)
#define PG8_STA(bufoff, kbase, h, vv) do { if constexpr (GATHER) { PG8_STAGE(bufoff, kbase, vv[h]); } else { PG8_STAGE(bufoff, (kbase) + (h) * hstep, voffA); } } while (0)
    Unit cur, nxt; int ui = 0;
    if (!S.next(0, cur)) return;
    f32x4 acc[2][2][4][2];
    if constexpr (MODE == 0 || MODE == 2) {
#pragma unroll
        for (int a = 0; a < 2; ++a)
#pragma unroll
            for (int b = 0; b < 2; ++b)
#pragma unroll
                for (int m = 0; m < 4; ++m)
#pragma unroll
                    for (int n = 0; n < 2; ++n) acc[a][b][m][n] = (f32x4){0.f, 0.f, 0.f, 0.f}; }
    bf16x8 At[4][2], B0[2][2], B1[2][2]; i32x8 At8[4], B08[2], B18[2]; i32x6 At6[4], B06[2], B16[2];
    unsigned voffA[2], vc[2][2];
    int vsa = (int)g.sa, vsb = (int)g.sb, vsb1 = (int)(g.sb1 ? g.sb1 : g.sb); if constexpr (MODE == 1 || MODE == 3) asm volatile("" : "+v"(vsa), "+v"(vsb), "+v"(vsb1));
#pragma unroll
    for (int i = 0; i < 2; ++i) voffA[i] = (unsigned)(Rr[i] * K + Cc[i]) * 2u;
    if constexpr (GATHER) PG8_AOFF(vc, 0);
    gcp cA = GATHER ? (gcp)g.A : S.a_base(g, cur); gcp cB = S.b_base(g, cur);
    PG8_STAGE(PG8_SB(0, 0), cB, voffB); PG8_STAGE(PG8_SB(0, 1), cB + hstep, voffB); PG8_STA(PG8_SA(0, 0), cA, 0, vc); PG8_STA(PG8_SA(0, 1), cA, 1, vc);
    if (wr == 1) PG8_BAR;
    PG8_WAIT_V(2); PG8_BAR;
    PG8_STAGE(PG8_SB(1, 0), cB + kstep, voffB); PG8_STAGE(PG8_SB(1, 1), cB + hstep + kstep, voffB);
    PG8_WAIT_V(4); PG8_BAR;
    for (;;) {
        const bool has_next = S.next(ui + 1, nxt);
        gcp nA = cA; gcp nB = cB;
        if (has_next) { nA = GATHER ? (gcp)g.A : S.a_base(g, nxt); nB = S.b_base(g, nxt); }
#define PG8_BODY(MMAF) { \
            const bool last = (t == nt - 2); \
            gcp a1 = cA + (size_t)(t + 1) * kstep; \
            gcp a2 = last ? nA : cA + (size_t)(t + 2) * kstep; gcp b2 = last ? nB : cB + (size_t)(t + 2) * kstep; \
            gcp b3 = b2 + kstep; \
            unsigned w2[2][2]; \
            if constexpr (GATHER) { \
                _Pragma("unroll") for (int h = 0; h < 2; ++h) _Pragma("unroll") for (int i = 0; i < 2; ++i) w2[h][i] = vc[h][i]; \
                if (last) { PG8_AOFF(w2, has_next ? ui + 1 : ui); } }                      \
              \
            PG8_LDB(B0, 0, 0); PG8_LDB(B1, 0, 1); PG8_SCHED; PG8_LDA(At, 0, 0); PG8_STA(PG8_SA(1, 0), a1, 0, vc); PG8_STA(PG8_SA(1, 1), a1, 1, vc); \
            PG8_WAIT_V(8); PG8_WAIT_L(0); PG8_BAR; MMAF(0, 0, At, B0); MMAF(0, 1, At, B1); PG8_BAR; PG8_SCHED; \
              \
            PG8_LDA(At, 0, 1); PG8_STAGE(PG8_SB(0, 0), b2, voffB); PG8_STAGE(PG8_SB(0, 1), b2 + hstep, voffB); \
            PG8_WAIT_V(6); PG8_WAIT_L(0); PG8_BAR; MMAF(1, 0, At, B0); MMAF(1, 1, At, B1); PG8_BAR; PG8_SCHED; \
              \
            PG8_LDB(B0, 1, 0); PG8_LDB(B1, 1, 1); PG8_SCHED; PG8_LDA(At, 1, 0); PG8_STA(PG8_SA(0, 0), a2, 0, w2); PG8_STA(PG8_SA(0, 1), a2, 1, w2); \
            PG8_WAIT_V(8); PG8_WAIT_L(0); PG8_BAR; PG8_MMA(0, 0, At, B0); PG8_MMA(0, 1, At, B1); PG8_BAR; PG8_SCHED; \
              \
            PG8_LDA(At, 1, 1); PG8_STAGE(PG8_SB(1, 0), b3, voffB); PG8_STAGE(PG8_SB(1, 1), b3 + hstep, voffB); \
            PG8_WAIT_V(6); PG8_WAIT_L(0); PG8_BAR; PG8_MMA(1, 0, At, B0); PG8_MMA(1, 1, At, B1); PG8_BAR; PG8_SCHED; }
        if constexpr (MODE == 1 || MODE == 3) {
            { const int t = 0; PG8_BODY(PG8_MMA0) }
#pragma unroll 1
            for (int t = 2; t < nt; t += 2) PG8_BODY(PG8_MMA)
        } else {
#pragma unroll 1
            for (int t = 0; t < nt; t += 2) PG8_BODY(PG8_MMA)
        }
        if (wr == 0) PG8_BAR;
        if constexpr (MODE == 1 || MODE == 3) asm volatile("s_nop 15\n\ts_nop 15" ::: "memory");
        E(acc, cur, wr, wc, fr, fq);
        if (!has_next) break;
        if constexpr (MODE == 0 || MODE == 2) {
#pragma unroll
            for (int a = 0; a < 2; ++a)
#pragma unroll
                for (int b = 0; b < 2; ++b)
#pragma unroll
                    for (int m = 0; m < 4; ++m)
#pragma unroll
                        for (int n = 0; n < 2; ++n) acc[a][b][m][n] = (f32x4){0.f, 0.f, 0.f, 0.f}; }
        cur = nxt; cA = nA; cB = nB; ++ui;
        if constexpr (GATHER) PG8_AOFF(vc, ui);
        if (wr == 1) PG8_BAR;
    }
    PG8_WAIT_V(0);
    PG8_BAR;
#undef PG8_SA
#undef PG8_SB
#undef PG8_STAGE
#undef PG8_LDA
#undef PG8_LDB
#undef PG8_MMA
#undef PG8_WAIT_V
#undef PG8_WAIT_L
#undef PG8_BAR
#undef PG8_SCHED
#undef PG8_AOFF
#undef PG8_BODY
#undef PG8_MMA0
#undef PG8_STA
}
}

constexpr size_t MiB = 1u << 20;
constexpr size_t WS_CTL = 0, CTL_ZERO_BYTES = 192 * 1024;
constexpr size_t WS_TOKINFO = 2 * MiB;
constexpr size_t WS_SW = 2 * MiB + 512 * 1024;
constexpr size_t WS_SWIN = 2 * MiB + 544 * 1024;
constexpr size_t WS_SA = 2 * MiB + 576 * 1024;
constexpr size_t WS_INV = 3 * MiB;
constexpr size_t WS_WIN = 4 * MiB;
constexpr size_t WS_WOUT = 11 * MiB;
constexpr size_t WS_WGU = 15 * MiB;
constexpr size_t WS_WD = 26 * MiB;
constexpr size_t WS_SGUW = 31 * MiB + 512 * 1024;
constexpr size_t WS_MWGU = 32 * MiB;
constexpr size_t WS_FSP = 88 * MiB;
constexpr size_t WS_MWD = 116 * MiB;
constexpr size_t WS_H16 = 144 * MiB;
constexpr size_t WS_XN = 208 * MiB;
constexpr size_t WS_HIDC = 240 * MiB;
constexpr size_t WS_Z = 272 * MiB;
constexpr size_t WS_MERGED = 384 * MiB;
constexpr size_t WS_HID = 272 * MiB;
constexpr size_t WS_FS = 360 * MiB;
constexpr size_t WS_END = 492 * MiB;
constexpr size_t HID_GAP = (size_t)SEQ * INW * 2 - (size_t)SEQ * FFD;
constexpr size_t OUT_MIX = 0, OUT_ROPE = 64 * MiB;
constexpr int CW_BAR = 4096;
constexpr int CW_CM = 32768;
constexpr int CW_CM2 = CW_CM + 2 * FFD;
constexpr int CW_GRP = 8192;
constexpr int CW_CNT = 16384;

constexpr int RING_BYTES = 131072;
constexpr int P2_K = 0, P2_KSTRIDE = 272, P2_V = 256 * P2_KSTRIDE, P2_SSQ = 2 * 256 * P2_KSTRIDE;
constexpr int P2_BYTES = P2_SSQ + 8192;
constexpr int ROWTAB_OFF = 139264, ROWTAB_UNITS = 32;
constexpr int LDSCTL_OFF = 155648, MISC_OFF = LDSCTL_OFF + 320, MOETBL_OFF = LDSCTL_OFF + 512;
constexpr int ROUTE_OFF = LDSCTL_OFF + 1024;
constexpr int LDS_BYTES = 159744;
static_assert(P2_BYTES <= LDSCTL_OFF && ROWTAB_OFF + ROWTAB_UNITS * 512 <= LDSCTL_OFF && ROUTE_OFF + 1024 <= LDS_BYTES && LDS_BYTES <= 163840, "LDS map");

typedef unsigned short bf16;
typedef unsigned v4u __attribute__((ext_vector_type(4)));
typedef unsigned v2u __attribute__((ext_vector_type(2)));
typedef float f32x4 __attribute__((ext_vector_type(4)));
typedef GAS unsigned gu32;
#define RLX_AGENT __ATOMIC_RELAXED, __HIP_MEMORY_SCOPE_AGENT
#define LDS_WAIT() asm volatile("s_waitcnt lgkmcnt(0)" ::: "memory")
#define VM_WAIT() asm volatile("s_waitcnt vmcnt(0)" ::: "memory")
__device__ __forceinline__ unsigned f2bf(float f) { unsigned u = __builtin_bit_cast(unsigned, f); return (u + 0x7fffu + ((u >> 16) & 1u)) >> 16; }
__device__ __forceinline__ unsigned pk2(float lo, float hi) { return f2bf(lo) | (f2bf(hi) << 16); }
__device__ __forceinline__ float bflo(unsigned w) { return __uint_as_float(w << 16); }
__device__ __forceinline__ float bfhi(unsigned w) { return __uint_as_float(w & 0xffff0000u); }

#define XB_TMO      128
#define XB_XCNT(j)  (256  + 64 * (j))
#define XB_XSUB(j)  (1280 + 64 * (j))
#define XB_XGEN(j)  (2304 + 64 * (j))
#define XB_TOP      3328
#define XB_TOPGEN   3392
#define XCD_BAR_WORDS 3456
#define XB_SPIN_CAP (1u << 18)

__device__ __forceinline__ unsigned xb_ld(unsigned* p)              { return __hip_atomic_load(p, __ATOMIC_RELAXED, __HIP_MEMORY_SCOPE_AGENT); }
__device__ __forceinline__ unsigned xb_add(unsigned* p, unsigned v) { return __hip_atomic_fetch_add(p, v, __ATOMIC_RELAXED, __HIP_MEMORY_SCOPE_AGENT); }
__device__ __forceinline__ unsigned xb_xcc_id() { return (unsigned)__builtin_amdgcn_s_getreg((3 << 11) | 20) & 0xFu; }
#define XB_SPIN(cond, bar) do { unsigned _sp = 0; while (cond) { __builtin_amdgcn_s_sleep(1); \
    if ((++_sp & 255u) == 0u) { if (xb_ld(&(bar)[XB_TMO])) break; if (_sp > XB_SPIN_CAP) { atomicAdd(&(bar)[XB_TMO], 1u); break; } } } } while (0)

struct XcdBarrier { unsigned* bar; unsigned x; volatile LAS unsigned* st; };

__device__ __forceinline__ XcdBarrier xcd_barrier_post(unsigned* bar, volatile LAS unsigned* st) {
    XcdBarrier b; b.bar = bar; b.x = xb_xcc_id(); b.st = st;
    if (threadIdx.x == 0) (void)xb_add(&bar[XB_XCNT(b.x)], 1u);
    return b;
}
__device__ __forceinline__ void xcd_barrier_complete(unsigned* bar, unsigned x, unsigned& nloc, unsigned& nx) {
    const unsigned G = gridDim.x * gridDim.y * gridDim.z;
    unsigned sum, cnt, mine, sp = 0u;
    for (;;) {
        sum = 0u; cnt = 0u; mine = 0u;
#pragma unroll
        for (unsigned j = 0; j < 16; ++j) { const unsigned c = xb_ld(&bar[XB_XCNT(j)]); sum += c; cnt += (c > 0u) ? 1u : 0u; mine = (j == x) ? c : mine; }
        if (sum == G) break;
        __builtin_amdgcn_s_sleep(1);
        if ((++sp & 255u) == 0u) { if (xb_ld(&bar[XB_TMO])) break; if (sp > XB_SPIN_CAP) { atomicAdd(&bar[XB_TMO], 1u); break; } }
    }
    nloc = mine > 0u ? mine : 1u; nx = cnt > 0u ? cnt : 1u;
}
__device__ __forceinline__ void xcd_barrier(const XcdBarrier& b) {
    asm volatile("s_waitcnt vmcnt(0)" ::: "memory");
    __syncthreads();
    if (threadIdx.x == 0) {
        unsigned* bar = b.bar;
        __builtin_amdgcn_s_waitcnt(0);
        unsigned nloc = b.st[0], nx = b.st[1];
        if (nloc == 0u) { xcd_barrier_complete(bar, b.x, nloc, nx); b.st[0] = nloc; b.st[1] = nx; }
        const unsigned old = xb_add(&bar[XB_XSUB(b.x)], 1u);
        const unsigned gen = old / nloc;
        if (old + 1u == (gen + 1u) * nloc) {
            __builtin_amdgcn_fence(__ATOMIC_RELEASE, "agent");
            asm volatile("s_waitcnt vmcnt(0)" ::: "memory");
            const unsigned og = xb_add(&bar[XB_TOP], 1u);
            const unsigned tg = og / nx;
            if (og + 1u == (tg + 1u) * nx) xb_add(&bar[XB_TOPGEN], 1u);
            else XB_SPIN(xb_ld(&bar[XB_TOPGEN]) == tg, bar);
            __builtin_amdgcn_fence(__ATOMIC_ACQUIRE, "agent");
            xb_add(&bar[XB_XGEN(b.x)], 1u);
            asm volatile("s_waitcnt vmcnt(0)" ::: "memory");
        } else {
            XB_SPIN(xb_ld(&bar[XB_XGEN(b.x)]) == gen, bar);
            __builtin_amdgcn_fence(__ATOMIC_ACQUIRE, "agent");
            asm volatile("s_waitcnt vmcnt(0)" ::: "memory");
        }
    }
    __syncthreads();
}
__device__ __forceinline__ void grp_barrier(unsigned* bar, unsigned* cnt, unsigned nmem, volatile LAS unsigned* ep) {
    asm volatile("s_waitcnt vmcnt(0)" ::: "memory");
    __syncthreads();
    if (threadIdx.x == 0) {
        const unsigned e = ep[0] + 1u; ep[0] = e; const unsigned target = e * nmem;
        xb_add(cnt, 1u);
        XB_SPIN(xb_ld(cnt) < target, bar);
        __builtin_amdgcn_fence(__ATOMIC_ACQUIRE, "agent");
        asm volatile("s_waitcnt vmcnt(0)" ::: "memory");
    }
    __syncthreads();
}

struct Args { const void* in[22]; float* out; unsigned char* ws; int ph_lo, ph_hi; };
struct Frame {
    LAS unsigned char* lds;
    int tid, lane, wave, G, bid;
};
constexpr int NWAVES = 8;
__device__ __forceinline__ int seq_group_bid(const Frame& F) { return (F.G & 7) == 0 ? (F.bid & 7) * (F.G >> 3) + (F.bid >> 3) : F.bid; }
constexpr int NR = 4;
__device__ __forceinline__ Frame opaque(const Frame& F0) { Frame F = F0; asm volatile("" : "+s"(F.G), "+s"(F.bid), "+s"(F.wave), "+v"(F.tid)); F.lane = F.tid & 63; return F; }

template <int CTRL> __device__ __forceinline__ float dpp_f(float v) { return __builtin_bit_cast(float, __builtin_amdgcn_update_dpp(0, __builtin_bit_cast(int, v), CTRL, 0xf, 0xf, true)); }
__device__ __forceinline__ float swap16_add(float v) { float a = v, b = v; asm volatile("s_nop 1\n\tv_permlane16_swap_b32 %0, %1" : "+v"(a), "+v"(b)); return a + b; }
__device__ __forceinline__ float swap32_add(float v) { float a = v, b = v; asm volatile("s_nop 1\n\tv_permlane32_swap_b32 %0, %1" : "+v"(a), "+v"(b)); return a + b; }
__device__ __forceinline__ float swap32_max(float v) { float a = v, b = v; asm volatile("s_nop 1\n\tv_permlane32_swap_b32 %0, %1" : "+v"(a), "+v"(b)); return fmaxf(a, b); }
__device__ __forceinline__ unsigned xchg32(unsigned v, int hi) { unsigned a = v, b = v; asm volatile("s_nop 1\n\tv_permlane32_swap_b32 %0, %1" : "+v"(a), "+v"(b)); return hi ? a : b; }
__device__ __forceinline__ void pl32_swap(unsigned& a, unsigned& b) { asm volatile("s_nop 1\n\tv_permlane32_swap_b32 %0, %1" : "+v"(a), "+v"(b)); }
__device__ __forceinline__ void pl32_swap2(v2u& a, v2u& b) { unsigned ax = a.x, ay = a.y, bx = b.x, by = b.y; pl32_swap(ax, bx); pl32_swap(ay, by); a = (v2u){ax, ay}; b = (v2u){bx, by}; }
__device__ __forceinline__ void store_pair16(GAS unsigned char* rowbase16  , int hi, v2u a, v2u b) {
    pl32_swap2(a, b);
    *(GAS v4u*)(rowbase16 + (hi ? 16 : 0)) = (v4u){a.x, a.y, b.x, b.y};
}
__device__ __forceinline__ float xor1_add(float v) { return v + dpp_f<0xB1>(v); }
__device__ __forceinline__ float wave_sum(float v) {
    v += dpp_f<0xB1>(v); v += dpp_f<0x4E>(v); v += dpp_f<0x141>(v); v += dpp_f<0x140>(v);
    v = swap16_add(v); v = swap32_add(v);
    return v;
}
__device__ __forceinline__ float gelu_tanh(float x) {
    const float t = x * __builtin_fmaf(x * x, -1.4426950408889634f * 1.5957691216057308f * 0.044715f, -1.4426950408889634f * 1.5957691216057308f);
    return x * __builtin_amdgcn_rcpf(1.0f + __builtin_amdgcn_exp2f(t));
}

__device__ __forceinline__ void p0_transpose_item(const GAS float* W, int K, int N, GAS bf16* WT, int mode, LAS float* scr, int item, int lane) {
    const int nblk = N / 32, kb = item / nblk, nb = item % nblk, k0 = 64 * kb, n0 = 32 * nb;
    const int d0 = mode == 0 ? n0 : ((n0 >> 7) * 256 + (n0 & 127) + (mode == 2 ? 128 : 0));
    float wv[32];
#pragma unroll
    for (int i = 0; i < 32; ++i) { const int kk = 2 * i + (lane >> 5); wv[i] = __builtin_nontemporal_load(&W[(size_t)(k0 + kk) * N + n0 + (lane & 31)]); }
#pragma unroll
    for (int i = 0; i < 32; ++i) { const int kk = 2 * i + (lane >> 5); scr[kk * 33 + (lane & 31)] = wv[i]; }
    LDS_WAIT(); asm volatile("" ::: "memory");
    const int c = lane & 7;
#pragma unroll
    for (int j = 0; j < 4; ++j) { const int n = (lane >> 3) + 8 * j; const LAS float* s = scr + (8 * c) * 33 + n;
        v4u o; o.x = pk2(s[0 * 33], s[1 * 33]); o.y = pk2(s[2 * 33], s[3 * 33]); o.z = pk2(s[4 * 33], s[5 * 33]); o.w = pk2(s[6 * 33], s[7 * 33]);
        *(GAS v4u*)(WT + (size_t)(d0 + n) * K + k0 + 8 * c) = o; }
    LDS_WAIT(); asm volatile("" ::: "memory");
}

__device__ __forceinline__ unsigned pk4_fp8(float a, float b, float c, float d) { int w = __builtin_amdgcn_cvt_pk_fp8_f32(a, b, 0, false); w = __builtin_amdgcn_cvt_pk_fp8_f32(c, d, w, true); return (unsigned)w; }
__device__ __forceinline__ void store_quad8(GAS unsigned char* rowbase, int hi, const unsigned (&p)[4]) {
    unsigned p0 = p[0], p1 = p[1], p2 = p[2], p3 = p[3];
    pl32_swap(p0, p2); pl32_swap(p1, p3);
    *(GAS v4u*)(rowbase + (hi ? 16 : 0)) = (v4u){p0, p2, p1, p3};
}
__device__ __forceinline__ void p0_transpose_item8(const GAS float* W, int K, int N, GAS unsigned char* WT, int mode, float scale, LAS float* scr, int item, int lane) {
    const int nblk = N / 32, kb = item / nblk, nb = item % nblk, k0 = 64 * kb, n0 = 32 * nb;
    const int d0 = mode == 0 ? n0 : ((n0 >> 7) * 256 + (n0 & 127) + (mode == 2 ? 128 : 0));
    float wv[32];
#pragma unroll
    for (int i = 0; i < 32; ++i) { const int kk = 2 * i + (lane >> 5); wv[i] = __builtin_nontemporal_load(&W[(size_t)(k0 + kk) * N + n0 + (lane & 31)]); }
#pragma unroll
    for (int i = 0; i < 32; ++i) { const int kk = 2 * i + (lane >> 5); scr[kk * 33 + (lane & 31)] = wv[i]; }
    LDS_WAIT(); asm volatile("" ::: "memory");
    const int c = lane & 7;
#pragma unroll
    for (int j = 0; j < 4; ++j) { const int n = (lane >> 3) + 8 * j; const LAS float* sp = scr + (8 * c) * 33 + n;
        v2u o; o.x = pk4_fp8(sp[0 * 33] * scale, sp[1 * 33] * scale, sp[2 * 33] * scale, sp[3 * 33] * scale); o.y = pk4_fp8(sp[4 * 33] * scale, sp[5 * 33] * scale, sp[6 * 33] * scale, sp[7 * 33] * scale);
        __builtin_nontemporal_store(o, (GAS v2u*)(WT + (size_t)(d0 + n) * K + k0 + 8 * c)); }
    LDS_WAIT(); asm volatile("" ::: "memory");
}

typedef float f32x16v __attribute__((ext_vector_type(16))); typedef unsigned v6u __attribute__((ext_vector_type(6)));
__device__ __forceinline__ v6u pk32_fp6(const float (&x)[32]) {
    f32x16v a, b;
#pragma unroll
    for (int i = 0; i < 16; ++i) { a[i] = x[i]; b[i] = x[16 + i]; }
    return __builtin_bit_cast(v6u, __builtin_amdgcn_cvt_scalef32_2xpk16_fp6_f32(a, b, 1.0f));
}
__device__ __forceinline__ void store_f6_group(GAS unsigned char* row, int group  , v6u p) {
    GAS unsigned char* b = row + (group >> 2) * 128 + (group & 3) * 16;
    *(GAS v4u*)b = (v4u){p[0], p[1], p[2], p[3]}; *(GAS v4u*)(b + 64) = (v4u){p[4], p[5], 0u, 0u};
}
__device__ __forceinline__ void p0_transpose_item6(const GAS float* W, int K, int N, GAS unsigned char* WT, int mode, float scale, LAS float* scr, int item, int lane) {
    const int nblk = N / 32, kb = item / nblk, nb = item % nblk, k0 = 64 * kb, n0 = 32 * nb;
    const int d0 = mode == 0 ? n0 : ((n0 >> 7) * 256 + (n0 & 127) + (mode == 2 ? 128 : 0));
    float wv[32];
#pragma unroll
    for (int i = 0; i < 32; ++i) { const int kk = 2 * i + (lane >> 5); wv[i] = __builtin_nontemporal_load(&W[(size_t)(k0 + kk) * N + n0 + (lane & 31)]); }
#pragma unroll
    for (int i = 0; i < 32; ++i) { const int kk = 2 * i + (lane >> 5); scr[kk * 33 + (lane & 31)] = wv[i]; }
    LDS_WAIT(); asm volatile("" ::: "memory");
    const int n = lane & 31, grp = lane >> 5; float x[32];
#pragma unroll
    for (int i = 0; i < 32; ++i) x[i] = scr[(32 * grp + i) * 33 + n] * scale;
    store_f6_group(WT + (size_t)(d0 + n) * K, 2 * kb + grp, pk32_fp6(x));
    LDS_WAIT(); asm volatile("" ::: "memory");
}
__device__ __forceinline__ unsigned pk4_i8(float a, float b, float c, float d, float inv) {
    int q0 = (int)__builtin_rintf(a * inv), q1 = (int)__builtin_rintf(b * inv), q2 = (int)__builtin_rintf(c * inv), q3 = (int)__builtin_rintf(d * inv);
    q0 = q0 < -127 ? -127 : (q0 > 127 ? 127 : q0); q1 = q1 < -127 ? -127 : (q1 > 127 ? 127 : q1); q2 = q2 < -127 ? -127 : (q2 > 127 ? 127 : q2); q3 = q3 < -127 ? -127 : (q3 > 127 ? 127 : q3);
    return ((unsigned)q0 & 255u) | (((unsigned)q1 & 255u) << 8) | (((unsigned)q2 & 255u) << 16) | ((unsigned)q3 << 24);
}
__device__ __forceinline__ void store_row_bf16(GAS bf16* orow, int lane, const f32x4 (&v)[4]) {
    GAS unsigned long long* o8 = (GAS unsigned long long*)orow + lane;
#pragma unroll
    for (int j = 0; j < 4; ++j) o8[64 * j] = (unsigned long long)pk2(v[j].x, v[j].y) | ((unsigned long long)pk2(v[j].z, v[j].w) << 32);
}
__device__ __forceinline__ void load_row_f32(const GAS float* p, int lane, f32x4 (&v)[4]) {
    const GAS f32x4* xr = (const GAS f32x4*)p + lane;
#pragma unroll
    for (int j = 0; j < 4; ++j) v[j] = xr[64 * j];
}
__device__ __forceinline__ void load_row_f32_nt(const GAS float* p, int lane, f32x4 (&v)[4]) {
    const GAS f32x4* xr = (const GAS f32x4*)p + lane;
#pragma unroll
    for (int j = 0; j < 4; ++j) v[j] = __builtin_nontemporal_load(xr + 64 * j);
}
__device__ __forceinline__ void load_row_bf16(const GAS bf16* p, int lane, f32x4 (&v)[4]) {
    const GAS v2u* xr = (const GAS v2u*)p + lane;
#pragma unroll
    for (int j = 0; j < 4; ++j) { const v2u w = xr[64 * j]; v[j] = (f32x4){bflo(w.x), bfhi(w.x), bflo(w.y), bfhi(w.y)}; }
}
template <int N> __device__ __forceinline__ void wave_sum_n(float (&v)[N]) {
#pragma unroll
    for (int q = 0; q < N; ++q) v[q] += dpp_f<0xB1>(v[q]);
#pragma unroll
    for (int q = 0; q < N; ++q) v[q] += dpp_f<0x4E>(v[q]);
#pragma unroll
    for (int q = 0; q < N; ++q) v[q] += dpp_f<0x141>(v[q]);
#pragma unroll
    for (int q = 0; q < N; ++q) v[q] += dpp_f<0x140>(v[q]);
#pragma unroll
    for (int q = 0; q < N; ++q) v[q] = swap16_add(v[q]);
#pragma unroll
    for (int q = 0; q < N; ++q) v[q] = swap32_add(v[q]);
}
__device__ __forceinline__ float row_ssq_local(const f32x4 (&v)[4]) {
    float s = 0.f;
#pragma unroll
    for (int j = 0; j < 4; ++j) s += (v[j].x * v[j].x + v[j].y * v[j].y) + (v[j].z * v[j].z + v[j].w * v[j].w);
    return s;
}
template <int CTRL> __device__ __forceinline__ float dpp_maxf(float v) { return fmaxf(v, dpp_f<CTRL>(v)); }
__device__ __forceinline__ float swap16_max(float v) { float a = v, b = v; asm volatile("s_nop 1\n\tv_permlane16_swap_b32 %0, %1" : "+v"(a), "+v"(b)); return fmaxf(a, b); }
template <int N> __device__ __forceinline__ void wave_max_n(float (&v)[N]) {
#pragma unroll
    for (int q = 0; q < N; ++q) v[q] = dpp_maxf<0xB1>(v[q]);
#pragma unroll
    for (int q = 0; q < N; ++q) v[q] = dpp_maxf<0x4E>(v[q]);
#pragma unroll
    for (int q = 0; q < N; ++q) v[q] = dpp_maxf<0x141>(v[q]);
#pragma unroll
    for (int q = 0; q < N; ++q) v[q] = dpp_maxf<0x140>(v[q]);
#pragma unroll
    for (int q = 0; q < N; ++q) v[q] = swap16_max(v[q]);
#pragma unroll
    for (int q = 0; q < N; ++q) v[q] = swap32_max(v[q]);
}
template <int N> __device__ __forceinline__ void store_rows_i8(GAS unsigned char* base, GAS float* sa, const f32x4 (&hh)[N][4], const int (&mm)[N], const bool (&ok)[N], int lane) {
    float am[N];
#pragma unroll
    for (int q = 0; q < N; ++q) { float m = 0.f;
#pragma unroll
        for (int j = 0; j < 4; ++j) m = fmaxf(fmaxf(m, fmaxf(fabsf(hh[q][j][0]), fabsf(hh[q][j][1]))), fmaxf(fabsf(hh[q][j][2]), fabsf(hh[q][j][3])));
        am[q] = m; }
    wave_max_n<N>(am);
#pragma unroll
    for (int q = 0; q < N; ++q) if (ok[q]) { const float inv = am[q] > 0.f ? 127.0f / am[q] : 0.f;
        GAS unsigned* o4 = (GAS unsigned*)(base + (size_t)mm[q] * D) + lane;
#pragma unroll
        for (int j = 0; j < 4; ++j) o4[64 * j] = pk4_i8(hh[q][j][0], hh[q][j][1], hh[q][j][2], hh[q][j][3], inv);
        if (lane == 0) sa[mm[q]] = am[q] * (1.0f / 127.0f); }
}
typedef _Float16 h16x4 __attribute__((ext_vector_type(4)));
__device__ __forceinline__ void load_row_fp8(const GAS unsigned char* p, int lane, f32x4 (&v)[4]) {
    const GAS unsigned* xr = (const GAS unsigned*)p + lane;
#pragma unroll
    for (int j = 0; j < 4; ++j) { const unsigned w = __builtin_nontemporal_load(xr + 64 * j);
        const auto lo = __builtin_amdgcn_cvt_pk_f32_fp8((int)w, false), hi2 = __builtin_amdgcn_cvt_pk_f32_fp8((int)w, true); v[j] = (f32x4){lo[0], lo[1], hi2[0], hi2[1]}; }
}
__device__ __forceinline__ void load_row_f16(const GAS _Float16* p, int lane, f32x4 (&v)[4]) {
    const GAS h16x4* xr = (const GAS h16x4*)p + lane;
#pragma unroll
    for (int j = 0; j < 4; ++j) { const h16x4 w = __builtin_nontemporal_load(xr + 64 * j); v[j] = (f32x4){(float)w[0], (float)w[1], (float)w[2], (float)w[3]}; }
}
__device__ __forceinline__ void store_row_f16(GAS _Float16* p, int lane, const f32x4 (&v)[4]) {
    GAS h16x4* xr = (GAS h16x4*)p + lane;
#pragma unroll
    for (int j = 0; j < 4; ++j) __builtin_nontemporal_store((h16x4){(_Float16)v[j][0], (_Float16)v[j][1], (_Float16)v[j][2], (_Float16)v[j][3]}, xr + 64 * j);
}
__device__ __forceinline__ float row_ssq(const f32x4 (&v)[4]) {
    float s = 0.f;
#pragma unroll
    for (int j = 0; j < 4; ++j) s += (v[j].x * v[j].x + v[j].y * v[j].y) + (v[j].z * v[j].z + v[j].w * v[j].w);
    return wave_sum(s);
}

#define AS4 __attribute__((address_space(4)))
constexpr int KA_OUT = 22 * 8, KA_WS = 23 * 8, KA_LO = 24 * 8, KA_HI = 24 * 8 + 4;
__device__ __forceinline__ const GAS float* ka_in(int idx) {
    int off = idx * 8; asm volatile("" : "+s"(off));
    const AS4 unsigned char* kp = (const AS4 unsigned char*)__builtin_amdgcn_kernarg_segment_ptr();
    return (const GAS float*)*(const void* const AS4*)(kp + off);
}
__device__ __forceinline__ GAS unsigned char* ka_ptr(int byte_off) {
    int off = byte_off; asm volatile("" : "+s"(off));
    const AS4 unsigned char* kp = (const AS4 unsigned char*)__builtin_amdgcn_kernarg_segment_ptr();
    return (GAS unsigned char*)*(void* const AS4*)(kp + off);
}
__device__ __forceinline__ int ka_int(int byte_off) {
    int off = byte_off; asm volatile("" : "+s"(off));
    const AS4 unsigned char* kp = (const AS4 unsigned char*)__builtin_amdgcn_kernarg_segment_ptr();
    return *(const AS4 int*)(kp + off);
}
typedef GAS bf16 gbf16;
#define WSP(ws, off) ((gbf16*)((ws) + (off)))

__device__ __forceinline__ void moe_table(const Frame& F, GAS unsigned char* ws) {
    LAS int* MOETBL = (LAS int*)(F.lds + MOETBL_OFF);
    __syncthreads();
    if (F.wave == 0) { gu32* ctl = (gu32*)ws; const int ln = F.lane;
        if (ln < NEXP) MOETBL[16 + ln] = (int)__hip_atomic_load(ctl + CW_CNT + 64 * ln, RLX_AGENT);
        asm volatile("s_waitcnt lgkmcnt(0)" ::: "memory");
        if (ln == 0) { int acc_t = 0; MOETBL[0] = 0;
#pragma unroll
            for (int e = 0; e < NEXP; ++e) { acc_t += (MOETBL[16 + e] + 255) >> 8; MOETBL[e + 1] = acc_t; } } }
    __syncthreads();
}

constexpr int I_MG = (D / 64) * (FFE / 32), I_MD = (FFE / 64) * (D / 32), N_MOE_ITEMS = NEXP * (2 * I_MG + I_MD);
constexpr int MOE_DEFER_PER_WAVE = 8;
__device__ __forceinline__ int win_idle_blocks(int G) { const int nu = (T / 256) * (INW / 256), rounds = (nu + G - 1) / G; const int busy = nu - (rounds - 1) * G; return busy < G ? G - busy : 0; }
__device__ __forceinline__ int moe_deferred(int G) { int n = DEPTH * win_idle_blocks(G) * NWAVES * MOE_DEFER_PER_WAVE; return n < N_MOE_ITEMS ? n : N_MOE_ITEMS; }
__device__ __forceinline__ void moe_convert_item(GAS unsigned char* ws, int r, LAS float* scr, int lane) {
    if (r < NEXP * I_MD) { const int e = r / I_MD; p0_transpose_item8(ka_in(21) + (size_t)e * FFE * D, FFE, D, ws + WS_MWD + (size_t)e * D * FFE, 0, MOE_WD_SCALE, scr, r % I_MD, lane); return; } r -= NEXP * I_MD;
    if (r < NEXP * I_MG) { const int e = r / I_MG; p0_transpose_item6(ka_in(19) + (size_t)e * D * FFE, D, FFE, ws + WS_MWGU + (size_t)e * 2 * FFE * D, 1, MOE_WG_SCALE, scr, r % I_MG, lane); return; } r -= NEXP * I_MG;
    { const int e = r / I_MG; p0_transpose_item6(ka_in(20) + (size_t)e * D * FFE, D, FFE, ws + WS_MWGU + (size_t)e * 2 * FFE * D, 2, MOE_WU_SCALE, scr, r % I_MG, lane); }
}

__device__ __forceinline__ void p0_strip_q(const Frame& F, const GAS float* W, int N, GAS unsigned char* WT, int mode, GAS float* sw, int nb) {
    const int lane = F.lane, w = F.wave, n0 = 32 * nb, K = D;
    const int d0 = mode == 0 ? n0 : ((n0 >> 7) * 256 + (n0 & 127) + (mode == 2 ? 128 : 0));
    LAS float* scr = (LAS float*)(F.lds + w * 17408);
    LAS float* cmx = (LAS float*)(F.lds + 8 * 17408);
    float m = 0.f;
#pragma unroll 1
    for (int b = 0; b < 2; ++b) {
        float wv[32];
#pragma unroll
        for (int i = 0; i < 32; ++i) { const int kk = 64 * (2 * w + b) + 2 * i + (lane >> 5); wv[i] = __builtin_nontemporal_load(&W[(size_t)kk * N + n0 + (lane & 31)]); }
#pragma unroll
        for (int i = 0; i < 32; ++i) { const int kk = 2 * i + (lane >> 5); scr[b * 2176 + kk * 33 + (lane & 31)] = wv[i]; m = fmaxf(m, fabsf(wv[i])); }
    }
    m = swap32_max(m);
    if (lane < 32) cmx[w * 32 + lane] = m;
    __syncthreads();
    float inv[4], cmv[4];
#pragma unroll
    for (int j = 0; j < 4; ++j) { const int n = (lane >> 3) + 8 * j; float c = cmx[n];
#pragma unroll
        for (int w2 = 1; w2 < 8; ++w2) c = fmaxf(c, cmx[w2 * 32 + n]);
        cmv[j] = c; inv[j] = c > 0.f ? 127.0f / c : 0.f; }
    const int c8 = lane & 7;
#pragma unroll
    for (int b = 0; b < 2; ++b) { const int k0 = 64 * (2 * w + b);
#pragma unroll
        for (int j = 0; j < 4; ++j) { const int n = (lane >> 3) + 8 * j; const LAS float* sp = scr + b * 2176 + (8 * c8) * 33 + n;
            v2u o; o.x = pk4_i8(sp[0 * 33], sp[1 * 33], sp[2 * 33], sp[3 * 33], inv[j]); o.y = pk4_i8(sp[4 * 33], sp[5 * 33], sp[6 * 33], sp[7 * 33], inv[j]);
            *(GAS v2u*)(WT + (size_t)(d0 + n) * K + k0 + 8 * c8) = o; } }
    if (w == 0 && c8 == 0) {
#pragma unroll
        for (int j = 0; j < 4; ++j) sw[d0 + (lane >> 3) + 8 * j] = cmv[j] * (1.0f / 127.0f); }
    __syncthreads();
}

__device__ __forceinline__ void ph_prologue(const Frame& F_) {
    const Frame F = opaque(F_);
    GAS unsigned char* ws = ka_ptr(KA_WS);
    const int gw = F.bid * NWAVES + F.wave, NGW = F.G * NWAVES;
    LAS float* scr = (LAS float*)(F.lds + F.wave * 16384);
    constexpr int I_OUT = (D / 64) * (D / 32), I_DN = (FFD / 64) * (D / 32);
    constexpr int S_IN = INW / 32, S_G = FFD / 32, N_STRIPS = 2 * S_IN + 2 * S_G;
    for (int st = F.bid; st < N_STRIPS; st += F.G) {
        if (st < 2 * S_IN) { const int l = st / S_IN; p0_strip_q(F, ka_in(3) + (size_t)l * D * INW, INW, ws + WS_WIN + (size_t)l * INW * D, 0, (GAS float*)(ws + WS_SWIN) + l * INW, st % S_IN); }
        else { const int r = st - 2 * S_IN; const GAS float* wg = ka_in(15); const GAS float* wu = ka_in(16);
               p0_strip_q(F, r < S_G ? wg : wu, FFD, ws + WS_WGU, r < S_G ? 1 : 2, (GAS float*)(ws + WS_SW), r % S_G); }
    }
    constexpr int N_DENSE = 2 * I_OUT + I_DN;
    const int ndefer = moe_deferred(F.G);
    const int NITEMS = N_DENSE + N_MOE_ITEMS - ndefer;
    auto do_item = [&](int it) {
        int r = it;
        if (r < 2 * I_OUT) { const int l = r / I_OUT; if (l == 0) p0_transpose_item(ka_in(11), D, D, WSP(ws, WS_WOUT), 0, scr, r % I_OUT, F.lane);
            else p0_transpose_item8(ka_in(11) + (size_t)D * D, D, D, ws + WS_WOUT + (size_t)2 * D * D, 0, WOUT_SCALE, scr, r % I_OUT, F.lane);
            return; } r -= 2 * I_OUT;
        if (r < I_DN) { p0_transpose_item8(ka_in(17), FFD, D, ws + WS_WD, 0, WD_SCALE, scr, r, F.lane); return; } r -= I_DN;
        moe_convert_item(ws, ndefer + r, scr, F.lane);
    };
    const int nx2 = (N_STRIPS > F.G && N_STRIPS - F.G < F.G) ? N_STRIPS - F.G : 0, nw1 = (F.G - nx2) * NWAVES;
    int EX = 2 * nw1; if (EX > NITEMS) EX = 0;
    if (EX > 0 && F.bid >= nx2) { const int w1 = (F.bid - nx2) * NWAVES + F.wave; do_item(w1); do_item(nw1 + w1); }
    for (int it = EX + gw; it < NITEMS; it += NGW) do_item(it);
    { const GAS int* positions = (const GAS int*)ka_in(1); GAS float* rope = (GAS float*)(ka_ptr(KA_OUT) + OUT_ROPE);
      for (int idx = F.bid * (NWAVES * 64) + F.tid; idx < T * 8; idx += F.G * NWAVES * 64) { const int row = idx >> 3, i = idx & 7;
          const float invf = exp2f(-(float)i * 0.125f * 18.931568569324174f); const float ang = (float)positions[row] * invf;
          rope[row * 16 + i] = cosf(ang); rope[row * 16 + 8 + i] = sinf(ang); } }
    { const GAS float* sw = ka_in(7); GAS unsigned* dst = (GAS unsigned*)(ws + WS_SGUW);
      for (int idx = F.bid * (NWAVES * 64) + F.tid; idx < DEPTH * 8 * BLK * BLK / 2; idx += F.G * NWAVES * 64) { const int s2 = (idx & 63) * 2, t = (idx >> 6) & 127;
          const float a = sw[(size_t)idx * 2], b = sw[(size_t)idx * 2 + 1]; dst[idx] = pk2(s2 <= t ? a : 0.f, s2 + 1 <= t ? b : 0.f); } }
    const GAS float* x = ka_in(0); gbf16* XN = WSP(ws, WS_XN);
    f32x4 gn[4]; load_row_f32(ka_in(2), F.lane, gn);
#pragma unroll 1
    for (int m0 = gw; m0 < T; m0 += NR * NGW) {
        f32x4 v[NR][4]; int mm[NR]; bool ok[NR]; float ss[NR];
#pragma unroll
        for (int q = 0; q < NR; ++q) { ok[q] = (m0 + q * NGW < T); mm[q] = ok[q] ? m0 + q * NGW : m0; load_row_f32_nt(x + (size_t)mm[q] * D, F.lane, v[q]); }
#pragma unroll
        for (int q = 0; q < NR; ++q) ss[q] = row_ssq_local(v[q]);
        wave_sum_n<NR>(ss);
#pragma unroll
        for (int q = 0; q < NR; ++q) { const float r = 1.0f / sqrtf(ss[q] * (1.0f / D) + EPS);
#pragma unroll
            for (int j = 0; j < 4; ++j) v[q][j] = v[q][j] * r * gn[j]; }
        store_rows_i8<NR>((GAS unsigned char*)XN, (GAS float*)(ws + WS_SA), v, mm, ok, F.lane);
    }
}

__device__ __forceinline__ void ph_gemm_in(const Frame& F_, int layer) {
    const Frame F = opaque(F_);
    GAS unsigned char* ws = ka_ptr(KA_WS);
    pg8::Gemm g{(const pg8::gbf*)WSP(ws, WS_XN), (const pg8::gbf*)(ws + WS_WIN + (size_t)layer * INW * D), D / 2, 0u, 0u, 0}; pg8::DenseSched S; S.init(T / 256, INW / 256, F.G, F.bid);
    pg8::EpiStoreq E{(pg8::gbf*)WSP(ws, WS_Z), INW, 0, (const GAS float*)(ws + WS_SA), (const GAS float*)(ws + WS_SWIN) + layer * INW};
    pg8::gemm_phase<pg8::EpiStoreq, pg8::DenseSched, false, 2>(F.lds, g, S, E);
    const int nidle = win_idle_blocks(F.G), first_idle = F.G - nidle;
    if (nidle > 0 && F.bid >= first_idle) {
        __syncthreads();
        LAS float* scr = (LAS float*)(F.lds + F.wave * 16384);
        const int ndefer = moe_deferred(F.G), per_layer = nidle * NWAVES * MOE_DEFER_PER_WAVE;
        const int w = (F.bid - first_idle) * NWAVES + F.wave;
#pragma unroll 1
        for (int j = 0; j < MOE_DEFER_PER_WAVE; ++j) { const int r = layer * per_layer + j * (nidle * NWAVES) + w; if (r < ndefer) moe_convert_item(ws, r, scr, F.lane); }
    }
}
__device__ __forceinline__ void ph_gemm_out(const Frame& F_, int layer) {
    const Frame F = opaque(F_);
    GAS unsigned char* ws = ka_ptr(KA_WS);
    pg8::DenseSched S; S.init(T / 256, D / 256, F.G, F.bid);
    pg8::EpiStore E{(pg8::gbf*)(ka_ptr(KA_OUT) + OUT_MIX), D, 0, 0};
    if (layer == 0) { pg8::Gemm g{(const pg8::gbf*)WSP(ws, WS_MERGED), (const pg8::gbf*)WSP(ws, WS_WOUT), D, 0u, 0u, 0}; pg8::gemm_phase<pg8::EpiStore, pg8::DenseSched, false>(F.lds, g, S, E); }
    else { S.gapA = (size_t)SEQ * D; pg8::Gemm g{(const pg8::gbf*)WSP(ws, WS_MERGED), (const pg8::gbf*)(ws + WS_WOUT + (size_t)2 * D * D), D / 2, 0x7d7d7d7du  , 0x79797979u  , 0}; pg8::gemm_phase<pg8::EpiStore, pg8::DenseSched, false, 1>(F.lds, g, S, E); }
}
__device__ __forceinline__ void ph_gemm_gu(const Frame& F_) {
    const Frame F = opaque(F_);
    GAS unsigned char* ws = ka_ptr(KA_WS);
    pg8::Gemm g{(const pg8::gbf*)WSP(ws, WS_XN), (const pg8::gbf*)WSP(ws, WS_WGU), D / 2, 0u, 0u, 0}; pg8::DenseSched S; S.init(T / 256, 2 * FFD / 256, F.G, F.bid);
    pg8::EpiSwiGLUq8 E{ws + WS_HID, FFD, 0, (const GAS float*)(ws + WS_SA), (const GAS float*)(ws + WS_SW), HID_SCALE, HID_GAP};
    pg8::gemm_phase<pg8::EpiSwiGLUq8, pg8::DenseSched, false, 2>(F.lds, g, S, E);
}
__device__ __forceinline__ void ph_gemm_down(const Frame& F_) {
    const Frame F = opaque(F_);
    GAS unsigned char* ws = ka_ptr(KA_WS);
    pg8::Gemm g{(const pg8::gbf*)WSP(ws, WS_HID), (const pg8::gbf*)WSP(ws, WS_WD), FFD / 2, 0x7d7d7d7du  , 0x78787878u  , 0}; pg8::DenseSched S; S.init(T / 256, D / 256, F.G, F.bid); S.gapA = HID_GAP;
    pg8::EpiStore E{(pg8::gbf*)(ka_ptr(KA_OUT) + OUT_MIX), D, 0, 0};
    pg8::gemm_phase<pg8::EpiStore, pg8::DenseSched, false, 1>(F.lds, g, S, E);
}
__device__ __forceinline__ void ph_moe_gu(const Frame& F_) {
    const Frame F = opaque(F_);
    GAS unsigned char* ws = ka_ptr(KA_WS);
    moe_table(F, ws);
    const LAS int* MOETBL = (const LAS int*)(F.lds + MOETBL_OFF);
    const int ntile = MOETBL[8];
    pg8::Gemm g{(const pg8::gbf*)WSP(ws, WS_XN), (const pg8::gbf*)WSP(ws, WS_MWGU), D / 2, 0x7e7e7e7eu  , 0x7a7a7a7au  , 0, 0x7b7b7b7bu  }; pg8::MoeSched S; S.init(ntile, 2 * FFE / 256, F.G, F.bid);
    S.pm0 = 0; S.tbl = MOETBL; S.inv = (const GAS int*)(ws + WS_INV); S.estride = (size_t)2 * FFE * D; S.a1 = nullptr; S.split = 0;
    LAS unsigned short* rowtab = (LAS unsigned short*)(F.lds + ROWTAB_OFF); S.rowtab = rowtab;
    { const int hf = F.tid >> 8, r = F.tid & 255; pg8::Unit u0;
      if (S.next(0, u0)) {
#pragma unroll 1
        for (int i0 = 0; i0 < ROWTAB_UNITS; i0 += 8) { int v[4]; bool ok[4];
#pragma unroll
          for (int k = 0; k < 4; ++k) { pg8::Unit u; const int i = i0 + 2 * k + hf; ok[k] = S.next(i, u); if (!ok[k]) u = u0;
              const int e = S.expert(u.pm), cnt = MOETBL[16 + e], local = (u.pm - MOETBL[e]) * 256 + r; const int t_ = S.inv[e * T + (local < cnt ? local : 0)]; v[k] = local < cnt ? t_ : 0; }
#pragma unroll
          for (int k = 0; k < 4; ++k) { const int i = i0 + 2 * k + hf; if (ok[k]) rowtab[i * 256 + r] = (unsigned short)v[k]; } } } }
    __syncthreads();
    static_assert(MOE_HID_SCALE == 4.f, "MOE_WU_SCALE carries the hidden scale");
    pg8::EpiSwiGLU8p E{ka_ptr(KA_OUT), ws + WS_HIDC, MOE_CHUNK, FFE};
    pg8::gemm_phase<pg8::EpiSwiGLU8p, pg8::MoeSched, true, 3>(F.lds, g, S, E);
}
__device__ __forceinline__ void ph_moe_down(const Frame& F_) {
    const Frame F = opaque(F_);
    GAS unsigned char* ws = ka_ptr(KA_WS);
    moe_table(F, ws);
    const LAS int* MOETBL = (const LAS int*)(F.lds + MOETBL_OFF);
    const int ntile = MOETBL[8];
    {
        pg8::Gemm g{(const pg8::gbf*)ka_ptr(KA_OUT), (const pg8::gbf*)WSP(ws, WS_MWD), FFE / 2, E8M0_HID, E8M0_WD, 0}; pg8::MoeSched S; S.init(2 * MOE_CHUNK, D / 256, F.G, F.bid);
        S.pm0 = 0; S.tbl = MOETBL; S.inv = (const GAS int*)(ws + WS_INV); S.estride = (size_t)D * FFE; S.rowtab = nullptr; S.a1 = (pg8::gcp)(ws + WS_HIDC); S.split = MOE_CHUNK;
        pg8::EpiStore8 E{ws + WS_FS, D, 0, MOE_FS_SCALE};
        pg8::gemm_phase<pg8::EpiStore8, pg8::MoeSched, false, 1>(F.lds, g, S, E);
    }
    const int ntail = ntile - 2 * MOE_CHUNK;
    if (ntail > 0) {
        pg8::Gemm g{(const pg8::gbf*)WSP(ws, WS_HIDC), (const pg8::gbf*)WSP(ws, WS_MWD), FFE / 2, E8M0_HID, E8M0_WD, 4}; pg8::MoeTailSched S;
        S.nunits = ntail * 4 * MOE_SPLITK; S.G = F.G; S.c = F.bid; S.pm0a = MOE_CHUNK; S.tbl = MOETBL; S.estride = (size_t)D * FFE; S.nks = MOE_SPLITK;
        pg8::EpiStore E{(pg8::gbf*)WSP(ws, WS_FSP), D, 2 * MOE_CHUNK, (size_t)MOE_TAIL_TILES * 256 * D};
        pg8::gemm_phase<pg8::EpiStore, pg8::MoeTailSched, false, 1>(F.lds, g, S, E);
    }
}

typedef float f32x16 __attribute__((ext_vector_type(16)));
typedef short s16x8 __attribute__((ext_vector_type(8)));
typedef short s16x4 __attribute__((ext_vector_type(4)));
typedef float f32x2_t __attribute__((ext_vector_type(2))); typedef __bf16 bf16x2_t __attribute__((ext_vector_type(2)));
__device__ __forceinline__ unsigned cvtpk(float lo, float hi) { f32x2_t v = {lo, hi}; bf16x2_t b = __builtin_convertvector(v, bf16x2_t); return __builtin_bit_cast(unsigned, b); }
__device__ __forceinline__ int crow(int r, int hi) { return (r & 3) + 8 * (r >> 2) + 4 * hi; }
__device__ __forceinline__ int kimg_off(int row, int chunk) { return row * 128 + ((chunk ^ ((row >> 1) & 7)) << 4); }
__device__ __forceinline__ int vimg_off(int row, int chunk) { return row * 128 + ((((chunk >> 2) ^ ((row >> 1) & 1)) << 6) | ((chunk & 3) << 4)); }
__device__ __forceinline__ s16x4 tr16(const LAS unsigned char* p) { return __builtin_bit_cast(s16x4, __builtin_amdgcn_ds_read_tr16_b64_v4i16((LAS s16x4*)p)); }
#define MFMA32(a, b, c) __builtin_amdgcn_mfma_f32_32x32x16_bf16((a), (b), (c), 0, 0, 0)

__device__ __forceinline__ void ph_mixer(const Frame& F_, int layer) {
    const Frame F = opaque(F_);
    GAS unsigned char* ws = ka_ptr(KA_WS);
    const gbf16* Z = WSP(ws, WS_Z); gbf16* MERGED = WSP(ws, WS_MERGED);
    const GAS float* rope = (const GAS float*)(ka_ptr(KA_OUT) + OUT_ROPE);
    LAS unsigned char* Kimg = F.lds; LAS unsigned char* Vimg = F.lds + 65536; LAS float* ssq = (LAS float*)(F.lds + P2_SSQ);
#define STAGE_LANES int tid_s = F.tid; asm volatile("" : "+v"(tid_s)); const int lane = tid_s & 63, qr = lane & 31, hi = lane >> 5, i16 = lane & 15, tq = i16 >> 2, tp = i16 & 3, g16 = (lane >> 4) & 1; (void)qr; (void)hi; (void)tq; (void)tp; (void)g16
    for (int unit = seq_group_bid(F); unit < BATCH * (SEQ / BLK); unit += F.G) {
        const int b = unit / (SEQ / BLK), nb = unit % (SEQ / BLK);
        const int row0 = b * SEQ + nb * BLK;
        __syncthreads();
        {
            int tid_s = F.tid; asm volatile("" : "+v"(tid_s));
            const int j = tid_s >> 1, kvh = tid_s & 1; const int row = row0 - BLK + j;
            const bool ok = (nb > 0 || j >= BLK);
            LAS unsigned char* kd = Kimg + kvh * 32768; LAS unsigned char* vd = Vimg + kvh * 32768;
            {
                v4u vv[8];
#pragma unroll
                for (int c = 0; c < 8; ++c) vv[c] = (v4u){0u, 0u, 0u, 0u};
                if (ok) { const GAS v4u* vp = (const GAS v4u*)(Z + (size_t)row * INW + ZV + kvh * HD);
#pragma unroll
                    for (int c = 0; c < 8; ++c) vv[c] = vp[c]; }
#pragma unroll
                for (int c = 0; c < 8; ++c) *(LAS v4u*)(vd + vimg_off(j, c)) = vv[c];
            }
            {
                v4u kk[8];
#pragma unroll
                for (int c = 0; c < 8; ++c) kk[c] = (v4u){0u, 0u, 0u, 0u};
                if (ok) { const GAS v4u* kp = (const GAS v4u*)(Z + (size_t)row * INW + ZK + kvh * HD);
#pragma unroll
                    for (int c = 0; c < 8; ++c) kk[c] = kp[c];
                    const GAS f32x4* rp = (const GAS f32x4*)(rope + (size_t)row * 16);
                    const f32x4 c0 = rp[0], c1 = rp[1], s0 = rp[2], s1 = rp[3];
                    float cs[8] = {c0[0], c0[1], c0[2], c0[3], c1[0], c1[1], c1[2], c1[3]}, sn[8] = {s0[0], s0[1], s0[2], s0[3], s1[0], s1[1], s1[2], s1[3]};
                    float r1[8], r2[8];
#pragma unroll
                    for (int i = 0; i < 4; ++i) { const float a0 = bflo(kk[0][i]), a1 = bfhi(kk[0][i]), b0 = bflo(kk[1][i]), b1 = bfhi(kk[1][i]);
                        r1[2 * i] = a0 * cs[2 * i] - b0 * sn[2 * i]; r2[2 * i] = b0 * cs[2 * i] + a0 * sn[2 * i];
                        r1[2 * i + 1] = a1 * cs[2 * i + 1] - b1 * sn[2 * i + 1]; r2[2 * i + 1] = b1 * cs[2 * i + 1] + a1 * sn[2 * i + 1]; }
#pragma unroll
                    for (int i = 0; i < 4; ++i) { kk[0][i] = pk2(r1[2 * i], r1[2 * i + 1]); kk[1][i] = pk2(r2[2 * i], r2[2 * i + 1]); }
                }
#pragma unroll
                for (int c = 0; c < 8; ++c) *(LAS v4u*)(kd + kimg_off(j, c)) = kk[c];
            }
        }
        __syncthreads();
        {
            STAGE_LANES;
            const int h = F.wave, kvh = h >> 2;
            const float sink2 = ka_in(4)[layer * NQH + h] * 1.4426950408889634f; const float sc = 0.125f * 1.4426950408889634f;
            const GAS float* g_a = ka_in(9) + layer * ATTW;
            const LAS unsigned char* Kb = Kimg + kvh * 32768; const LAS unsigned char* Vb = Vimg + kvh * 32768;
            int koff[4];
#pragma unroll
            for (int d0 = 0; d0 < 4; ++d0) koff[d0] = kimg_off(qr, 2 * d0 + hi);
            int voff[2];
#pragma unroll
            for (int d0 = 0; d0 < 2; ++d0) voff[d0] = (4 * hi + tq) * 128 + ((d0 ^ (tq >> 1)) << 6) + 32 * g16 + 8 * tp;
            v4u qwn[4]; f32x4 rpn[4];
            { const int row = row0 + qr; const GAS v4u* qp = (const GAS v4u*)(Z + (size_t)row * INW + ZQ + h * HD + 8 * hi); const GAS f32x4* rp = (const GAS f32x4*)(rope + (size_t)row * 16);
#pragma unroll
              for (int d0 = 0; d0 < 4; ++d0) { qwn[d0] = qp[2 * d0]; rpn[d0] = rp[d0]; } }
#pragma unroll 1
            for (int qi = 0; qi < 4; ++qi) {
                const int row = row0 + 32 * qi + qr;
                s16x8 qf[4];
                { v4u qw[4]; f32x4 rpc[4];
#pragma unroll
                  for (int d0 = 0; d0 < 4; ++d0) { qw[d0] = qwn[d0]; rpc[d0] = rpn[d0]; }
                  if (qi < 3) { const int rown = row + 32; const GAS v4u* qp = (const GAS v4u*)(Z + (size_t)rown * INW + ZQ + h * HD + 8 * hi); const GAS f32x4* rp = (const GAS f32x4*)(rope + (size_t)rown * 16);
#pragma unroll
                      for (int d0 = 0; d0 < 4; ++d0) { qwn[d0] = qp[2 * d0]; rpn[d0] = rp[d0]; } }
                  { v4u pw;
#pragma unroll
                    for (int e = 0; e < 4; ++e) pw[e] = xchg32(qw[0][e], hi);
                    const f32x4 c0 = rpc[0], c1 = rpc[1], s0 = rpc[2], s1 = rpc[3];
                    const float cs[8] = {c0[0], c0[1], c0[2], c0[3], c1[0], c1[1], c1[2], c1[3]}, sn[8] = {s0[0], s0[1], s0[2], s0[3], s1[0], s1[1], s1[2], s1[3]};
                    const float sg = hi ? 1.0f : -1.0f; float o8[8];
#pragma unroll
                    for (int e = 0; e < 4; ++e) { o8[2 * e] = bflo(qw[0][e]) * cs[2 * e] + sg * bflo(pw[e]) * sn[2 * e]; o8[2 * e + 1] = bfhi(qw[0][e]) * cs[2 * e + 1] + sg * bfhi(pw[e]) * sn[2 * e + 1]; }
#pragma unroll
                    for (int e = 0; e < 4; ++e) qw[0][e] = cvtpk(o8[2 * e], o8[2 * e + 1]); }
#pragma unroll
                  for (int d0 = 0; d0 < 4; ++d0) qf[d0] = __builtin_bit_cast(s16x8, qw[d0]); }
                f32x16 st[5];
#pragma unroll
                for (int a = 0; a < 5; ++a) {
                    const int kt = qi + a;
                    f32x16 acc;
#pragma unroll
                    for (int r = 0; r < 16; ++r) acc[r] = 0.f;
                    if (nb > 0 || kt >= 4) {
#pragma unroll
                        for (int d0 = 0; d0 < 4; ++d0) { const s16x8 kf = *(const LAS s16x8*)(Kb + kt * 4096 + koff[d0]); acc = MFMA32(kf, qf[d0], acc); }
                    }
                    st[a] = acc;
                }
                float mx = -INFINITY;
#pragma unroll
                for (int a = 0; a < 5; ++a) { const bool tile_ok = (nb > 0) || (qi + a >= 4);
#pragma unroll
                    for (int r = 0; r < 16; ++r) { const int kr = crow(r, hi); bool valid = tile_ok; if (a == 0) valid = valid && (kr > qr); if (a == 4) valid = valid && (kr <= qr);
                        const float v = valid ? st[a][r] : -INFINITY; st[a][r] = v; mx = fmaxf(mx, v); } }
                mx = swap32_max(mx);
                const float M = fmaxf(mx * sc, sink2);
                float lsum = 0.f;
#pragma unroll
                for (int a = 0; a < 5; ++a)
#pragma unroll
                    for (int r = 0; r < 16; ++r) { const float p = __builtin_amdgcn_exp2f(st[a][r] * sc - M); st[a][r] = p; lsum += p; }
                lsum = swap32_add(lsum);
                lsum += __builtin_amdgcn_exp2f(sink2 - M);
                f32x16 o0, o1;
#pragma unroll
                for (int r = 0; r < 16; ++r) { o0[r] = 0.f; o1[r] = 0.f; }
#pragma unroll
                for (int a = 0; a < 5; ++a) {
                    const int kt = qi + a;
                    if (nb > 0 || kt >= 4) {
#pragma unroll
                        for (int s2 = 0; s2 < 2; ++s2) {
                            v4u pw; pw.x = cvtpk(st[a][8 * s2], st[a][8 * s2 + 1]); pw.y = cvtpk(st[a][8 * s2 + 2], st[a][8 * s2 + 3]); pw.z = cvtpk(st[a][8 * s2 + 4], st[a][8 * s2 + 5]); pw.w = cvtpk(st[a][8 * s2 + 6], st[a][8 * s2 + 7]);
                            const s16x8 pf = __builtin_bit_cast(s16x8, pw);
                            const LAS unsigned char* vb = Vb + (32 * kt + 16 * s2) * 128;
                            { const s16x4 lo = tr16(vb + voff[0]), h4 = tr16(vb + 8 * 128 + voff[0]); const s16x8 vf = __builtin_shufflevector(lo, h4, 0, 1, 2, 3, 4, 5, 6, 7); o0 = MFMA32(vf, pf, o0); }
                            { const s16x4 lo = tr16(vb + voff[1]), h4 = tr16(vb + 8 * 128 + voff[1]); const s16x8 vf = __builtin_shufflevector(lo, h4, 0, 1, 2, 3, 4, 5, 6, 7); o1 = MFMA32(vf, pf, o1); }
                        }
                    }
                }
                const float il = 1.0f / lsum; float sq = 0.f;
#pragma unroll
                for (int r = 0; r < 16; ++r) { o0[r] *= il; o1[r] *= il; sq += o0[r] * o0[r] + o1[r] * o1[r]; }
                sq = swap32_add(sq);
                if (hi == 0) ssq[(32 * qi + qr) * 8 + h] = sq;
                const GAS float* gap = g_a + h * HD + 4 * hi;
                f32x4 ga[4], gb[4];
#pragma unroll
                for (int g4 = 0; g4 < 4; ++g4) { ga[g4] = *(const GAS f32x4*)(gap + 8 * g4); gb[g4] = *(const GAS f32x4*)(gap + 32 + 8 * g4); }
                __syncthreads();
                float rs;
                { const LAS float* sp = ssq + (32 * qi + qr) * 8; const f32x4 p0 = *(const LAS f32x4*)sp, p1 = *(const LAS f32x4*)(sp + 4);
                  const float tot = ((p0[0] + p0[1]) + (p0[2] + p0[3])) + ((p1[0] + p1[1]) + (p1[2] + p1[3])); rs = 1.0f / sqrtf(tot * (1.0f / 512.0f) + EPS); }
                if (layer == 0) {
                GAS unsigned char* orow = (GAS unsigned char*)(MERGED + (size_t)row * D + h * HD);
                v2u pa[4], pb[4];
#pragma unroll
                for (int g4 = 0; g4 < 4; ++g4) {
                    pa[g4] = (v2u){cvtpk(o0[4 * g4] * rs * ga[g4][0], o0[4 * g4 + 1] * rs * ga[g4][1]), cvtpk(o0[4 * g4 + 2] * rs * ga[g4][2], o0[4 * g4 + 3] * rs * ga[g4][3])};
                    pb[g4] = (v2u){cvtpk(o1[4 * g4] * rs * gb[g4][0], o1[4 * g4 + 1] * rs * gb[g4][1]), cvtpk(o1[4 * g4 + 2] * rs * gb[g4][2], o1[4 * g4 + 3] * rs * gb[g4][3])};
                }
#pragma unroll
                for (int k = 0; k < 4; k += 2) { store_pair16(orow + 16 * k, hi, pa[k], pa[k + 1]); store_pair16(orow + 64 + 16 * k, hi, pb[k], pb[k + 1]); }
                } else {
                GAS unsigned char* orow = (GAS unsigned char*)MERGED + (size_t)(row >> 12) * (SEQ * D) + (size_t)row * D + h * HD;
                unsigned pa[4], pb[4]; const float rq = rs * MERGED_SCALE;
#pragma unroll
                for (int g4 = 0; g4 < 4; ++g4) {
                    pa[g4] = pk4_fp8(o0[4 * g4] * rq * ga[g4][0], o0[4 * g4 + 1] * rq * ga[g4][1], o0[4 * g4 + 2] * rq * ga[g4][2], o0[4 * g4 + 3] * rq * ga[g4][3]);
                    pb[g4] = pk4_fp8(o1[4 * g4] * rq * gb[g4][0], o1[4 * g4 + 1] * rq * gb[g4][1], o1[4 * g4 + 2] * rq * gb[g4][2], o1[4 * g4 + 3] * rq * gb[g4][3]);
                }
                store_quad8(orow, hi, pa); store_quad8(orow + 32, hi, pb); }
            }
        }
        __syncthreads();
        {
            STAGE_LANES;
            const int g = F.wave, hf = lane & 1; LAS unsigned char* vnl = F.lds + g * 16384;
            const GAS float* lg = ka_in(5) + layer * SGUW + g * HD + hf * 32; const GAS float* lb = ka_in(6) + layer * SGUW + g * HD + hf * 32;
            v4u zraw[4][4];
#pragma unroll
            for (int p = 0; p < 4; ++p) { const GAS v4u* zp = (const GAS v4u*)(Z + (size_t)(row0 + 32 * p + (lane >> 1)) * INW + ZVV + g * HD + hf * 32);
#pragma unroll
                for (int c = 0; c < 4; ++c) zraw[p][c] = zp[c]; }
#pragma unroll
            for (int p = 0; p < 4; ++p) {
                const int sidx = 32 * p + (lane >> 1);
                float v[32];
#pragma unroll
                for (int c = 0; c < 4; ++c) { const v4u w = zraw[p][c];
#pragma unroll
                    for (int e = 0; e < 4; ++e) { v[8 * c + 2 * e] = gelu_tanh(bflo(w[e])); v[8 * c + 2 * e + 1] = gelu_tanh(bfhi(w[e])); } }
                float mu = 0.f;
#pragma unroll
                for (int d = 0; d < 32; ++d) mu += v[d];
                mu = xor1_add(mu);
                mu *= (1.0f / 64.0f); float var = 0.f;
#pragma unroll
                for (int d = 0; d < 32; ++d) { v[d] -= mu; var += v[d] * v[d]; }
                var = xor1_add(var);
                const float rs = 1.0f / sqrtf(var * (1.0f / 64.0f) + EPS);
#pragma unroll
                for (int c = 0; c < 4; ++c) { float t[8];
#pragma unroll
                    for (int e = 0; e < 8; ++e) t[e] = v[8 * c + e] * rs * lg[8 * c + e] + lb[8 * c + e];
                    v4u w; w.x = cvtpk(t[0], t[1]); w.y = cvtpk(t[2], t[3]); w.z = cvtpk(t[4], t[5]); w.w = cvtpk(t[6], t[7]);
                    *(LAS v4u*)(vnl + vimg_off(sidx, 4 * hf + c)) = w; }
            }
            __syncthreads();
            const GAS unsigned char* Wb = (const GAS unsigned char*)(ws + WS_SGUW) + (size_t)(layer * 8 + g) * (BLK * BLK * 2);
            const GAS float* sgu_b = ka_in(8) + (layer * 8 + g) * BLK; const GAS float* g_s = ka_in(10) + layer * SGUW;
            int vo[2];
#pragma unroll
            for (int d0 = 0; d0 < 2; ++d0) vo[d0] = (8 * hi + tq) * 128 + ((d0 ^ (tq >> 1)) << 6) + 32 * g16 + 8 * tp;
            s16x8 wfn[8]; v2u uvan[4], uvbn[4]; float bsn;
#define SGU_LOADS(tbx) do { const int t_ = 32 * (tbx) + qr; \
                _Pragma("unroll") for (int ks = 0; ks < 2 * (tbx) + 2; ++ks) wfn[ks] = *(const GAS s16x8*)(Wb + (size_t)t_ * 256 + 32 * ks + 16 * hi); \
                bsn = sgu_b[t_]; const GAS unsigned char* urow_ = (const GAS unsigned char*)(Z + (size_t)(row0 + t_) * INW + ZU + g * HD) + (hi ? 16 : 0); \
                _Pragma("unroll") for (int k = 0; k < 4; k += 2) { const v4u la = *(const GAS v4u*)(urow_ + 16 * k), lb = *(const GAS v4u*)(urow_ + 64 + 16 * k); \
                    uvan[k] = (v2u){la.x, la.y}; uvan[k + 1] = (v2u){la.z, la.w}; uvbn[k] = (v2u){lb.x, lb.y}; uvbn[k + 1] = (v2u){lb.z, lb.w}; } } while (0)
            SGU_LOADS(0);
#pragma unroll
            for (int tb = 0; tb < 4; ++tb) {
                const int t = 32 * tb + qr; const int row = row0 + t;
                f32x16 c0, c1;
#pragma unroll
                for (int r = 0; r < 16; ++r) { c0[r] = 0.f; c1[r] = 0.f; }
                s16x8 wf[8]; v2u uva[4], uvb[4];
#pragma unroll
                for (int ks = 0; ks < 2 * tb + 2; ++ks) wf[ks] = wfn[ks];
#pragma unroll
                for (int g4 = 0; g4 < 4; ++g4) { uva[g4] = uvan[g4]; uvb[g4] = uvbn[g4]; }
#pragma unroll
                for (int k = 0; k < 4; k += 2) { pl32_swap2(uva[k], uva[k + 1]); pl32_swap2(uvb[k], uvb[k + 1]); }
                const float bs = bsn;
                if (tb < 3) SGU_LOADS(tb + 1);
#pragma unroll
                for (int ks = 0; ks < 2 * tb + 2; ++ks) {
                    const LAS unsigned char* vb = vnl + 16 * ks * 128;
                    { const s16x4 lo = tr16(vb + vo[0]), h4 = tr16(vb + 4 * 128 + vo[0]); const s16x8 vf = __builtin_shufflevector(lo, h4, 0, 1, 2, 3, 4, 5, 6, 7); c0 = MFMA32(vf, wf[ks], c0); }
                    { const s16x4 lo = tr16(vb + vo[1]), h4 = tr16(vb + 4 * 128 + vo[1]); const s16x8 vf = __builtin_shufflevector(lo, h4, 0, 1, 2, 3, 4, 5, 6, 7); c1 = MFMA32(vf, wf[ks], c1); }
                }
                float sq = 0.f;
#pragma unroll
                for (int g4 = 0; g4 < 4; ++g4) {
                    const v2u ua = uva[g4], ub = uvb[g4];
                    c0[4 * g4] = gelu_tanh(bflo(ua.x)) * (c0[4 * g4] + bs); c0[4 * g4 + 1] = gelu_tanh(bfhi(ua.x)) * (c0[4 * g4 + 1] + bs); c0[4 * g4 + 2] = gelu_tanh(bflo(ua.y)) * (c0[4 * g4 + 2] + bs); c0[4 * g4 + 3] = gelu_tanh(bfhi(ua.y)) * (c0[4 * g4 + 3] + bs);
                    c1[4 * g4] = gelu_tanh(bflo(ub.x)) * (c1[4 * g4] + bs); c1[4 * g4 + 1] = gelu_tanh(bfhi(ub.x)) * (c1[4 * g4 + 1] + bs); c1[4 * g4 + 2] = gelu_tanh(bflo(ub.y)) * (c1[4 * g4 + 2] + bs); c1[4 * g4 + 3] = gelu_tanh(bfhi(ub.y)) * (c1[4 * g4 + 3] + bs);
                }
#pragma unroll
                for (int r = 0; r < 16; ++r) sq += c0[r] * c0[r] + c1[r] * c1[r];
                sq = swap32_add(sq);
                if (hi == 0) ssq[1024 + t * 8 + g] = sq;
                const GAS float* gsp = g_s + g * HD + 4 * hi;
                f32x4 ga[4], gb[4];
#pragma unroll
                for (int g4 = 0; g4 < 4; ++g4) { ga[g4] = *(const GAS f32x4*)(gsp + 8 * g4); gb[g4] = *(const GAS f32x4*)(gsp + 32 + 8 * g4); }
                __syncthreads();
                float rs;
                { const LAS float* sp = ssq + 1024 + t * 8; const f32x4 p0 = *(const LAS f32x4*)sp, p1 = *(const LAS f32x4*)(sp + 4);
                  const float tot = ((p0[0] + p0[1]) + (p0[2] + p0[3])) + ((p1[0] + p1[1]) + (p1[2] + p1[3])); rs = 1.0f / sqrtf(tot * (1.0f / 512.0f) + EPS); }
                if (layer == 0) {
                GAS unsigned char* orow = (GAS unsigned char*)(MERGED + (size_t)row * D + ATTW + g * HD);
                v2u pa[4], pb[4];
#pragma unroll
                for (int g4 = 0; g4 < 4; ++g4) {
                    pa[g4] = (v2u){cvtpk(c0[4 * g4] * rs * ga[g4][0], c0[4 * g4 + 1] * rs * ga[g4][1]), cvtpk(c0[4 * g4 + 2] * rs * ga[g4][2], c0[4 * g4 + 3] * rs * ga[g4][3])};
                    pb[g4] = (v2u){cvtpk(c1[4 * g4] * rs * gb[g4][0], c1[4 * g4 + 1] * rs * gb[g4][1]), cvtpk(c1[4 * g4 + 2] * rs * gb[g4][2], c1[4 * g4 + 3] * rs * gb[g4][3])};
                }
#pragma unroll
                for (int k = 0; k < 4; k += 2) { store_pair16(orow + 16 * k, hi, pa[k], pa[k + 1]); store_pair16(orow + 64 + 16 * k, hi, pb[k], pb[k + 1]); }
                } else {
                GAS unsigned char* orow = (GAS unsigned char*)MERGED + (size_t)(row >> 12) * (SEQ * D) + (size_t)row * D + ATTW + g * HD;
                unsigned pa[4], pb[4]; const float rq = rs * MERGED_SCALE;
#pragma unroll
                for (int g4 = 0; g4 < 4; ++g4) {
                    pa[g4] = pk4_fp8(c0[4 * g4] * rq * ga[g4][0], c0[4 * g4 + 1] * rq * ga[g4][1], c0[4 * g4 + 2] * rq * ga[g4][2], c0[4 * g4 + 3] * rq * ga[g4][3]);
                    pb[g4] = pk4_fp8(c1[4 * g4] * rq * gb[g4][0], c1[4 * g4 + 1] * rq * gb[g4][1], c1[4 * g4 + 2] * rq * gb[g4][2], c1[4 * g4 + 3] * rq * gb[g4][3]);
                }
                store_quad8(orow, hi, pa); store_quad8(orow + 32, hi, pb); }
            }
        }
    }
    __syncthreads();
#undef SGU_LOADS
#undef STAGE_LANES
}

template <int layer> __device__ __forceinline__ void ph_norm_mix(const Frame& F_) {
    const Frame F = opaque(F_);
    GAS unsigned char* ws = ka_ptr(KA_WS);
    const gbf16* MIX = (const gbf16*)(ka_ptr(KA_OUT) + OUT_MIX); gbf16* XN = WSP(ws, WS_XN);
    GAS _Float16* H16 = (GAS _Float16*)(ws + WS_H16);
    const GAS float* x = ka_in(0);
    f32x4 gpost[4], gffn[4]; load_row_f32(ka_in(12) + layer * D, F.lane, gpost); load_row_f32(ka_in(13) + layer * D, F.lane, gffn);
    const int rpb = (T + F.G - 1) / F.G;
    const int rb0 = seq_group_bid(F) * rpb, rb1 = (rb0 + rpb < T) ? rb0 + rpb : T;
    LAS unsigned* sel = (LAS unsigned*)(F.lds + ROUTE_OFF);
    const GAS float* moe_router = ka_in(18);
    LAS float* xscr = (LAS float*)(F.lds + F.wave * 9216);
    constexpr int RT_OFF = NWAVES * 9216;
    static_assert(NR == 4 && RT_OFF + 32768 <= ROWTAB_OFF, "norm_mix LDS layout");
    const LAS f32x4* rt = (const LAS f32x4*)(F.lds + RT_OFF);
    if (layer == 1) {
        for (int idx = F.tid; idx < 2048; idx += NWAVES * 64) { const int jc = idx >> 7, half = (idx >> 6) & 1, ln = idx & 63, k = 4 * ln + 256 * (jc >> 2) + (jc & 3);
            ((LAS f32x4*)(F.lds + RT_OFF))[idx] = *(const GAS f32x4*)(moe_router + (size_t)k * 8 + 4 * half); }
        __syncthreads();
    }
    GAS v4u* TOKINFO = (GAS v4u*)(ws + WS_TOKINFO);
#pragma unroll 1
    for (int m0 = rb0 + F.wave; m0 < rb1; m0 += NR * NWAVES) {
        f32x4 v[NR][4], hh[NR][4]; int mm[NR]; bool ok[NR];
#pragma unroll
        for (int q = 0; q < NR; ++q) { ok[q] = (m0 + q * NWAVES < rb1); mm[q] = ok[q] ? m0 + q * NWAVES : m0;
            load_row_bf16(MIX + (size_t)mm[q] * D, F.lane, v[q]);
            if (layer == 0) load_row_f32_nt(x + (size_t)mm[q] * D, F.lane, hh[q]); else load_row_f16(H16 + (size_t)mm[q] * D, F.lane, hh[q]); }
        float ss[NR];
#pragma unroll
        for (int q = 0; q < NR; ++q) ss[q] = row_ssq_local(v[q]);
        wave_sum_n<NR>(ss);
#pragma unroll
        for (int q = 0; q < NR; ++q) { const float r = 1.0f / sqrtf(ss[q] * (1.0f / D) + EPS);
#pragma unroll
            for (int j = 0; j < 4; ++j) hh[q][j] = hh[q][j] + v[q][j] * r * gpost[j];
            if (ok[q]) store_row_f16(H16 + (size_t)mm[q] * D, F.lane, hh[q]);
            ss[q] = row_ssq_local(hh[q]); }
        wave_sum_n<NR>(ss);
#pragma unroll
        for (int q = 0; q < NR; ++q) { const float r2 = 1.0f / sqrtf(ss[q] * (1.0f / D) + EPS);
#pragma unroll
            for (int j = 0; j < 4; ++j) hh[q][j] = hh[q][j] * r2 * gffn[j];
            if (ok[q]) {
                if (layer == 0) {   }
                } }
        if (layer == 1) {
#pragma unroll
            for (int b = 0; b < 2; ++b) {
#pragma unroll
                for (int qq = 0; qq < 2; ++qq) { LAS float* xs = xscr + qq * (32 * 36) + (F.lane >> 3) * 36 + 4 * (F.lane & 7);
#pragma unroll
                    for (int j = 0; j < 4; ++j) *(LAS f32x4*)(xs + 8 * j * 36) = hh[2 * b + qq][j] * MOE_XN_SCALE; }
                LDS_WAIT(); asm volatile("" ::: "memory");
                { const int qq = F.lane >> 5, gi = F.lane & 31; const LAS float* xs = xscr + qq * (32 * 36) + gi * 36; float xv[32];
#pragma unroll
                  for (int c = 0; c < 8; ++c) { const f32x4 t4 = *(const LAS f32x4*)(xs + 4 * c); xv[4 * c] = t4[0]; xv[4 * c + 1] = t4[1]; xv[4 * c + 2] = t4[2]; xv[4 * c + 3] = t4[3]; }
                  const v6u p = pk32_fp6(xv);
                  const int mq = qq ? mm[2 * b + 1] : mm[2 * b]; const bool okq = qq ? ok[2 * b + 1] : ok[2 * b];
                  if (okq) store_f6_group((GAS unsigned char*)XN + (size_t)mq * D, gi, p); }
                LDS_WAIT(); asm volatile("" ::: "memory");
            }
        }
        if (layer == 0) store_rows_i8<NR>((GAS unsigned char*)XN, (GAS float*)(ws + WS_SA), hh, mm, ok, F.lane);
        if (layer == 1) {
            float lg[NR][8];
#pragma unroll
            for (int q = 0; q < NR; ++q)
#pragma unroll
                for (int e = 0; e < 8; ++e) lg[q][e] = 0.f;
#pragma unroll
            for (int j = 0; j < 4; ++j)
#pragma unroll
                for (int c = 0; c < 4; ++c) { const f32x4 wa = rt[((j * 4 + c) * 2) * 64 + F.lane], wb = rt[((j * 4 + c) * 2 + 1) * 64 + F.lane];
#pragma unroll
                    for (int q = 0; q < NR; ++q) { const float y = hh[q][j][c];
                        lg[q][0] += y * wa[0]; lg[q][1] += y * wa[1]; lg[q][2] += y * wa[2]; lg[q][3] += y * wa[3]; lg[q][4] += y * wb[0]; lg[q][5] += y * wb[1]; lg[q][6] += y * wb[2]; lg[q][7] += y * wb[3]; } }
#pragma unroll
            for (int q = 0; q < NR; ++q) wave_sum_n<8>(lg[q]);
#pragma unroll
            for (int q = 0; q < NR; ++q) {
                int e1 = 0; float v1 = lg[q][0];
#pragma unroll
                for (int e = 1; e < 8; ++e) if (lg[q][e] > v1) { v1 = lg[q][e]; e1 = e; }
                int e2 = -1; float v2 = -3.0e38f;
#pragma unroll
                for (int e = 0; e < 8; ++e) if (e != e1 && lg[q][e] > v2) { v2 = lg[q][e]; e2 = e; }
                const float w1 = 1.0f / (1.0f + __expf(v2 - v1)), w2 = 1.0f - w1;
                if (ok[q] && F.lane == 0) { sel[mm[q] - rb0] = (unsigned)e1 | ((unsigned)e2 << 8);
                    GAS float* ti = (GAS float*)(TOKINFO + mm[q]); ti[1] = w1; ti[3] = w2; } }
        }
    }
    if (layer == 1) {
        __syncthreads();
        {
            gu32* ctl = (gu32*)ws; GAS int* INV = (GAS int*)(ws + WS_INV);
            const unsigned e = (unsigned)F.wave; const int nrows = rb1 - rb0;
            int lane_t = F.tid; asm volatile("" : "+v"(lane_t)); lane_t &= 63;
            int cnt = 0;
            for (int r0 = 0; r0 < nrows; r0 += 64) { const int r = r0 + lane_t; const unsigned sl = r < nrows ? sel[r] : 0xffffu;
                cnt += __popcll(__ballot((sl & 0xffu) == e || (sl >> 8) == e)); }
            int base = 0;
            if (cnt > 0 && lane_t == 0) base = (int)__hip_atomic_fetch_add(ctl + CW_CNT + 64 * e, (unsigned)cnt, RLX_AGENT);
            base = __builtin_amdgcn_readfirstlane(base);
            int done = 0;
            for (int r0 = 0; r0 < nrows; r0 += 64) { const int r = r0 + lane_t; const unsigned sl = r < nrows ? sel[r] : 0xffffu;
                const bool a = (sl & 0xffu) == e, b2 = (sl >> 8) == e; const unsigned long long mk = __ballot(a || b2);
                if (a || b2) { const int rank = base + done + (int)__builtin_amdgcn_mbcnt_hi((unsigned)(mk >> 32), __builtin_amdgcn_mbcnt_lo((unsigned)mk, 0u)); INV[e * T + rank] = rb0 + r;
                    GAS unsigned* ti = (GAS unsigned*)(TOKINFO + rb0 + r); ti[a ? 0 : 2] = e | ((unsigned)rank << 4); }
                done += __popcll(mk); }
        }
        __syncthreads();
    }
}
__device__ __forceinline__ void ph_norm_ffn0(const Frame& F_) {
    const Frame F = opaque(F_);
    GAS unsigned char* ws = ka_ptr(KA_WS);
    const gbf16* FB = (const gbf16*)(ka_ptr(KA_OUT) + OUT_MIX); gbf16* XN = WSP(ws, WS_XN);
    GAS _Float16* H16 = (GAS _Float16*)(ws + WS_H16);
    const bool grp = (F.G & 7) == 0;
    const int NGW = grp ? (F.G >> 3) * NWAVES : F.G * NWAVES, gw = grp ? (F.bid & 7) * SEQ + (F.bid >> 3) * NWAVES + F.wave : F.bid * NWAVES + F.wave, mend = grp ? (F.bid & 7) * SEQ + SEQ : T;
    f32x4 gpost[4], gnx[4]; load_row_f32(ka_in(14), F.lane, gpost); load_row_f32(ka_in(2) + D, F.lane, gnx);
#pragma unroll 1
    for (int m0 = gw; m0 < mend; m0 += NR * NGW) {
        f32x4 v[NR][4], hh[NR][4]; int mm[NR]; bool ok[NR];
#pragma unroll
        for (int q = 0; q < NR; ++q) { ok[q] = (m0 + q * NGW < mend); mm[q] = ok[q] ? m0 + q * NGW : m0; load_row_bf16(FB + (size_t)mm[q] * D, F.lane, v[q]); load_row_f16(H16 + (size_t)mm[q] * D, F.lane, hh[q]); }
        float ss[NR];
#pragma unroll
        for (int q = 0; q < NR; ++q) ss[q] = row_ssq_local(v[q]);
        wave_sum_n<NR>(ss);
#pragma unroll
        for (int q = 0; q < NR; ++q) { const float r = 1.0f / sqrtf(ss[q] * (1.0f / D) + EPS);
#pragma unroll
            for (int j = 0; j < 4; ++j) hh[q][j] = hh[q][j] + v[q][j] * r * gpost[j];
            if (ok[q]) store_row_f16(H16 + (size_t)mm[q] * D, F.lane, hh[q]);
            ss[q] = row_ssq_local(hh[q]); }
        wave_sum_n<NR>(ss);
#pragma unroll
        for (int q = 0; q < NR; ++q) { const float r2 = 1.0f / sqrtf(ss[q] * (1.0f / D) + EPS);
#pragma unroll
            for (int j = 0; j < 4; ++j) hh[q][j] = hh[q][j] * r2 * gnx[j]; }
        store_rows_i8<NR>((GAS unsigned char*)XN, (GAS float*)(ws + WS_SA), hh, mm, ok, F.lane);
    }
}
__device__ __forceinline__ void ph_final(const Frame& F_) {
    const Frame F = opaque(F_);
    GAS unsigned char* ws = ka_ptr(KA_WS);
    moe_table(F, ws);
    const LAS int* MOETBL = (const LAS int*)(F.lds + MOETBL_OFF);
    const GAS unsigned char* FS8 = ws + WS_FS; const gbf16* FSP = WSP(ws, WS_FSP); const GAS v4u* TOKINFO = (const GAS v4u*)(ws + WS_TOKINFO);
    const GAS _Float16* H16 = (const GAS _Float16*)(ws + WS_H16);
    GAS float* out = (GAS float*)ka_ptr(KA_OUT);
    const int gw = F.bid * NWAVES + F.wave, NGW = F.G * NWAVES;
    f32x4 gpost[4]; load_row_f32(ka_in(14) + D, F.lane, gpost);
    v4u tin[NR];
#pragma unroll
    for (int q = 0; q < NR; ++q) { const int mn = gw + q * NGW; tin[q] = TOKINFO[mn < T ? mn : 0]; }
#pragma unroll 1
    for (int m0 = gw; m0 < T; m0 += NR * NGW) {
        f32x4 a[NR][4], c[NR][4], hh[NR][4]; float w1[NR], w2[NR]; int mm[NR]; bool ok[NR]; v4u ti[NR]; int r1[NR], r2[NR];
#pragma unroll
        for (int q = 0; q < NR; ++q) { ok[q] = (m0 + q * NGW < T); mm[q] = ok[q] ? m0 + q * NGW : m0; ti[q] = tin[q]; }
#pragma unroll
        for (int q = 0; q < NR; ++q) { const int mn = m0 + NR * NGW + q * NGW; tin[q] = TOKINFO[mn < T ? mn : m0]; }
#pragma unroll
        for (int q = 0; q < NR; ++q) {
            const int e1 = (int)(ti[q].x & 15u), k1 = (int)(ti[q].x >> 4), e2 = (int)(ti[q].z & 15u), k2 = (int)(ti[q].z >> 4);
            w1[q] = __uint_as_float(ti[q].y); w2[q] = __uint_as_float(ti[q].w);
            r1[q] = __builtin_amdgcn_readfirstlane(MOETBL[e1] * 256 + k1); r2[q] = __builtin_amdgcn_readfirstlane(MOETBL[e2] * 256 + k2);
            load_row_f16(H16 + (size_t)mm[q] * D, F.lane, hh[q]);
            load_row_fp8(FS8 + (size_t)(r1[q] < 65536 ? r1[q] : 65535) * D, F.lane, a[q]);
            load_row_fp8(FS8 + (size_t)(r2[q] < 65536 ? r2[q] : 65535) * D, F.lane, c[q]); }
        { bool tail = false;
#pragma unroll
          for (int q = 0; q < NR; ++q) tail = tail || r1[q] >= 65536 || r2[q] >= 65536;
          if (tail) {
#pragma unroll
              for (int q = 0; q < NR; ++q) {
                  if (r1[q] >= 65536) { load_row_bf16(FSP + (size_t)(r1[q] - 65536) * D, F.lane, a[q]);
#pragma unroll
                      for (int j = 0; j < 4; ++j) a[q][j] = a[q][j] * MOE_FS_SCALE;
#pragma unroll 1
                      for (int ks = 1; ks < MOE_SPLITK; ++ks) { f32x4 p[4]; load_row_bf16(FSP + (size_t)ks * (MOE_TAIL_TILES * 256 * D) + (size_t)(r1[q] - 65536) * D, F.lane, p);
#pragma unroll
                          for (int j = 0; j < 4; ++j) a[q][j] = a[q][j] + p[j] * MOE_FS_SCALE; } }
                  if (r2[q] >= 65536) { load_row_bf16(FSP + (size_t)(r2[q] - 65536) * D, F.lane, c[q]);
#pragma unroll
                      for (int j = 0; j < 4; ++j) c[q][j] = c[q][j] * MOE_FS_SCALE;
#pragma unroll 1
                      for (int ks = 1; ks < MOE_SPLITK; ++ks) { f32x4 p[4]; load_row_bf16(FSP + (size_t)ks * (MOE_TAIL_TILES * 256 * D) + (size_t)(r2[q] - 65536) * D, F.lane, p);
#pragma unroll
                          for (int j = 0; j < 4; ++j) c[q][j] = c[q][j] + p[j] * MOE_FS_SCALE; } } } } }
        float ss[NR];
#pragma unroll
        for (int q = 0; q < NR; ++q) {
#pragma unroll
            for (int j = 0; j < 4; ++j) a[q][j] = a[q][j] * w1[q] + c[q][j] * w2[q];
            ss[q] = row_ssq_local(a[q]); }
        wave_sum_n<NR>(ss);
#pragma unroll
        for (int q = 0; q < NR; ++q) { const float r = 1.0f / sqrtf(ss[q] * (1.0f / D) + EPS * (MOE_FS_SCALE * MOE_FS_SCALE));
#pragma unroll
            for (int j = 0; j < 4; ++j) hh[q][j] = hh[q][j] + a[q][j] * r * gpost[j];
            if (ok[q]) { GAS f32x4* op = (GAS f32x4*)(out + (size_t)mm[q] * D) + F.lane;
#pragma unroll
                for (int j = 0; j < 4; ++j) __builtin_nontemporal_store(hh[q][j], op + 64 * j); } }
    }
}

__global__ void __launch_bounds__(NWAVES * 64, 2) fwd(Args args) {
    extern __shared__ __attribute__((aligned(16))) unsigned char lds_raw[];
    Frame F;
    F.lds = (LAS unsigned char*)lds_raw;
    F.tid = threadIdx.x; F.lane = F.tid & 63; F.wave = __builtin_amdgcn_readfirstlane(F.tid >> 6);
    F.G = gridDim.x; F.bid = blockIdx.x;
    for (int u = F.tid; u < (LDS_BYTES - LDSCTL_OFF) / 4; u += NWAVES * 64) ((LAS unsigned*)(F.lds + LDSCTL_OFF))[u] = 0u;
    __syncthreads();
    if (!MK_PER_PHASE_LAUNCH) (void)xcd_barrier_post((unsigned*)((gu32*)ka_ptr(KA_WS) + CW_BAR), (volatile LAS unsigned*)(F.lds + MISC_OFF) + 8);
    if (F.tid == 0) __hip_atomic_fetch_or((unsigned*)((gu32*)ka_ptr(KA_WS) + CW_GRP + 1024 + 64 * (F.bid & 7)), 1u << xb_xcc_id(), __ATOMIC_RELAXED, __HIP_MEMORY_SCOPE_AGENT);
    int grp_ok = 0;

    const int lo = ka_int(KA_LO), hi = ka_int(KA_HI);
    int ph = 0;
#define PH_ON (lo <= ph && ph < hi)
#define PH_END do { if (PH_ON && ph + 1 < hi) { if (!MK_PER_PHASE_LAUNCH) { if (grp_ok && ph >= 1 && ph <= 10) grp_barrier((unsigned*)((gu32*)ka_ptr(KA_WS) + CW_BAR), (unsigned*)((gu32*)ka_ptr(KA_WS) + CW_GRP + 64 * (F.bid & 7)), (unsigned)(F.G >> 3), (volatile LAS unsigned*)(F.lds + MISC_OFF) + 12); else { XcdBarrier bar; bar.bar = (unsigned*)((gu32*)ka_ptr(KA_WS) + CW_BAR); bar.x = xb_xcc_id(); bar.st = (volatile LAS unsigned*)(F.lds + MISC_OFF) + 8; xcd_barrier(bar); } } } ++ph; } while (0)

    if (PH_ON) ph_prologue(F);
    PH_END;
    if (!MK_PER_PHASE_LAUNCH && lo == 0 && hi == 15) {
        if (F.tid == 0) { unsigned ok = (F.G == 256) ? 1u : 0u;
            for (int g = 0; g < 8; ++g) { const unsigned m = xb_ld((unsigned*)((gu32*)ka_ptr(KA_WS) + CW_GRP + 1024 + 64 * g)); ok &= (m != 0u && (m & (m - 1u)) == 0u) ? 1u : 0u; }
            ((volatile LAS unsigned*)(F.lds + MISC_OFF))[13] = ok; }
        __syncthreads();
        grp_ok = __builtin_amdgcn_readfirstlane((int)((volatile LAS unsigned*)(F.lds + MISC_OFF))[13]);
    }
    for (int layer = 0; layer < DEPTH; ++layer) {
        if (PH_ON) ph_gemm_in(F, layer);
        PH_END;
        if (PH_ON) ph_mixer(F, layer);
        PH_END;
        if (PH_ON) ph_gemm_out(F, layer);
        PH_END;
        if (PH_ON) { if (layer == 0) ph_norm_mix<0>(F); else ph_norm_mix<1>(F); }
        PH_END;
        if (layer == 0) {
            if (PH_ON) ph_gemm_gu(F);
            PH_END;
            if (PH_ON) ph_gemm_down(F);
            PH_END;
            if (PH_ON) ph_norm_ffn0(F);
            PH_END;
        } else {
            if (PH_ON) ph_moe_gu(F);
            PH_END;
            if (PH_ON) ph_moe_down(F);
            PH_END;
            if (PH_ON) ph_final(F);
            PH_END;
        }
    }
#undef PH_ON
#undef PH_END
}
constexpr int N_PHASES = 1 + 2 * 4 + 3 + 2 + 1;

extern "C" void kernel_launch(void* const* d_in, const int* in_sizes, int n_in, void* d_out, int out_size, void* d_ws, size_t ws_size, hipStream_t stream) {
    static int grid = 0;
    if (grid == 0) {
        if (n_in != 22 || out_size != T * D || ws_size < WS_END) { fprintf(stderr, "kernel_launch: unexpected shapes (n_in %d, out %d, ws %zu); nothing launched\n", n_in, out_size, ws_size); grid = -1; return; }
        int dev = 0, cus = 0, per_cu = 0;
        if (hipGetDevice(&dev) != hipSuccess || hipDeviceGetAttribute(&cus, hipDeviceAttributeMultiprocessorCount, dev) != hipSuccess) { grid = -1; return; }
        if (hipFuncSetAttribute((const void*)fwd, hipFuncAttributeMaxDynamicSharedMemorySize, LDS_BYTES) != hipSuccess) { fprintf(stderr, "kernel_launch: hipFuncSetAttribute failed\n"); grid = -1; return; }
        if (hipOccupancyMaxActiveBlocksPerMultiprocessor(&per_cu, (const void*)fwd, NWAVES * 64, LDS_BYTES) != hipSuccess || per_cu < 1)
            fprintf(stderr, "kernel_launch: occupancy query reports %d workgroups per CU\n", per_cu);
        (void)hipGetLastError();
        grid = cus;
    }
    if (grid < 0) return;
    if (hipMemsetAsync((char*)d_ws + WS_CTL, 0, CTL_ZERO_BYTES, stream) != hipSuccess) return;
    Args a{};
    for (int i = 0; i < 22; ++i) a.in[i] = d_in[i];
    a.out = (float*)d_out; a.ws = (unsigned char*)d_ws;
#if MK_PER_PHASE_LAUNCH
    for (int p = 0; p < N_PHASES; ++p) { a.ph_lo = p; a.ph_hi = p + 1; hipLaunchKernelGGL(fwd, dim3(grid), dim3(NWAVES * 64), LDS_BYTES, stream, a); }
#else
    a.ph_lo = 0; a.ph_hi = N_PHASES;
    hipLaunchKernelGGL(fwd, dim3(grid), dim3(NWAVES * 64), LDS_BYTES, stream, a);
#endif
}
```
